# Optimizing an MI355X kernel written in HIP

```python
import jax, jax.numpy as jnp
from jax import lax
import numpy as np

D_MODEL = 1024
BATCH = 4
SEQ = 4096
DEPTH = 2
DEC_BATCH = 128
DEC_SEQ = 1
PAST_LEN = 16384
PAGE_SIZE = 128

N_A_LAYERS = DEPTH // 2
N_B_LAYERS = DEPTH - N_A_LAYERS
POOL_WINDOWS = (2, 4, 8, 16)
N_POOL_GROUPS = len(POOL_WINDOWS)
POOL_GROUP = D_MODEL // N_POOL_GROUPS
POOL_BUF = max(POOL_WINDOWS) - 1
HEAD_DIM = 64
N_HEADS = D_MODEL // HEAD_DIM
N_KV_HEADS = 4
GROUP = N_HEADS // N_KV_HEADS
KV_DIM = N_KV_HEADS * HEAD_DIM
WINDOW = 128
BLOCK = WINDOW
ROT_DIM = HEAD_DIM // 4
ROPE_THETA = 500000.0
D_FF = 2816
EPS = 1e-5

kernel_name = 'yoco_pool_swa_sink_macaron_step'


def _rmsnorm(x, g):
    xf = x.astype(jnp.float32)
    y = xf * lax.rsqrt(jnp.mean(xf * xf, axis=-1, keepdims=True) + EPS)
    return (y * g.astype(jnp.float32)).astype(x.dtype)


def _swiglu(x, wg, wu, wd):
    return (jax.nn.silu(x @ wg) * (x @ wu)) @ wd


def _rope(x, pos):
    half = ROT_DIM // 2
    inv = jnp.power(ROPE_THETA, -jnp.arange(half, dtype=jnp.float32) * (2.0 / ROT_DIM))
    ang = pos.astype(jnp.float32)[:, None] * inv[None, :]
    shp = (1, ang.shape[0]) + (1,) * (x.ndim - 3) + (half,)
    cos = jnp.cos(ang).reshape(shp)
    sin = jnp.sin(ang).reshape(shp)
    xf = x.astype(jnp.float32)
    x1 = xf[..., :half]
    x2 = xf[..., half:ROT_DIM]
    out = jnp.concatenate([x1 * cos - x2 * sin, x2 * cos + x1 * sin, xf[..., ROT_DIM:]], axis=-1)
    return out.astype(x.dtype)


def _pool_mixer(u, buf, pos0, w_pool, scale):
    B, T, D = u.shape
    ext_raw = jnp.concatenate([buf.astype(u.dtype), u], axis=1)
    ext = ext_raw.astype(jnp.float32)
    cs = jnp.concatenate([jnp.zeros((B, 1, D), jnp.float32), jnp.cumsum(ext, axis=1)], axis=1)
    end = cs[:, POOL_BUF + 1:POOL_BUF + 1 + T]
    pos = pos0 + jnp.arange(T)
    means = []
    for gi, w in enumerate(POOL_WINDOWS):
        c0, c1 = gi * POOL_GROUP, (gi + 1) * POOL_GROUP
        start = cs[:, POOL_BUF + 1 - w:POOL_BUF + 1 - w + T, c0:c1]
        cnt = jnp.minimum(w, pos + 1).astype(jnp.float32)[None, :, None]
        means.append((end[..., c0:c1] - start) / cnt)
    pooled = jnp.concatenate(means, axis=-1)
    diff = (pooled - u.astype(jnp.float32)).reshape(B, T, N_POOL_GROUPS, POOL_GROUP)
    mixed = jnp.einsum('btgc,gcd->btgd', diff, w_pool.astype(jnp.float32)).reshape(B, T, D)
    out = (mixed * scale.astype(jnp.float32)).astype(u.dtype)
    return out, ext_raw[:, -POOL_BUF:]


def _sink_attention(q, k, v, mask, sinks):
    s = jnp.einsum('bnqkgd,bnskd->bnkgqs', q.astype(jnp.float32), k.astype(jnp.float32)) * (HEAD_DIM ** -0.5)
    s = jnp.where(mask[None, :, None, None], s, -jnp.inf)
    sink = sinks.astype(jnp.float32).reshape(1, 1, N_KV_HEADS, GROUP, 1, 1)
    m = jnp.maximum(jnp.max(s, axis=-1, keepdims=True), sink)
    p = jnp.exp(s - m)
    denom = jnp.sum(p, axis=-1, keepdims=True) + jnp.exp(sink - m)
    return jnp.einsum('bnkgqs,bnskd->bnqkgd', p / denom, v.astype(jnp.float32))


def _window_attention(q, kk, vv, wb, pos0, sinks):
    B, T = q.shape[0], q.shape[1]
    qpos = pos0 + jnp.arange(T)
    kpos = pos0 - wb + jnp.arange(wb + T)
    if T % BLOCK == 0 and wb == BLOCK:
        nb = T // BLOCK
        qb = q.reshape(B, nb, BLOCK, N_KV_HEADS, GROUP, HEAD_DIM)
        kb = jnp.concatenate([kk[:, :T].reshape(B, nb, BLOCK, N_KV_HEADS, HEAD_DIM),
                              kk[:, wb:].reshape(B, nb, BLOCK, N_KV_HEADS, HEAD_DIM)], axis=2)
        vb = jnp.concatenate([vv[:, :T].reshape(B, nb, BLOCK, N_KV_HEADS, HEAD_DIM),
                              vv[:, wb:].reshape(B, nb, BLOCK, N_KV_HEADS, HEAD_DIM)], axis=2)
        qp = qpos.reshape(nb, BLOCK)
        kp = jnp.concatenate([kpos[:T].reshape(nb, BLOCK), kpos[wb:].reshape(nb, BLOCK)], axis=1)
    else:
        qb, kb, vb = q[:, None], kk[:, None], vv[:, None]
        qp, kp = qpos[None], kpos[None]
    d = qp[:, :, None] - kp[:, None, :]
    mask = (d >= 0) & (d < WINDOW) & (kp[:, None, :] >= 0)
    o = _sink_attention(qb, kb, vb, mask, sinks)
    return o.reshape(B, T, N_HEADS * HEAD_DIM).astype(q.dtype)


def _trunk(x, pos0, pool_bufs, k_buf, v_buf, norm_g, ffn_w_gate, ffn_w_up, ffn_w_down, pool_w,
           pool_scale, kv_norm_g, w_kv, w_q, w_o, attn_sinks, final_norm_g):
    B, T, _ = x.shape
    pos = pos0 + jnp.arange(T)
    wb = k_buf.shape[1]
    new_pool = []
    kk = vv = None
    for l in range(DEPTH):
        if l == N_A_LAYERS:
            kv = _rmsnorm(x, kv_norm_g) @ w_kv
            k_new = _rope(kv[..., :KV_DIM].reshape(B, T, N_KV_HEADS, HEAD_DIM), pos)
            v_new = kv[..., KV_DIM:].reshape(B, T, N_KV_HEADS, HEAD_DIM)
            kk = jnp.concatenate([k_buf.astype(k_new.dtype), k_new], axis=1)
            vv = jnp.concatenate([v_buf.astype(v_new.dtype), v_new], axis=1)
        x = x + 0.5 * _swiglu(_rmsnorm(x, norm_g[l, 0]), ffn_w_gate[l, 0], ffn_w_up[l, 0], ffn_w_down[l, 0])
        h = _rmsnorm(x, norm_g[l, 1])
        if l < N_A_LAYERS:
            out, nbuf = _pool_mixer(h, pool_bufs[l], pos0, pool_w[l], pool_scale[l])
            new_pool.append(nbuf)
        else:
            j = l - N_A_LAYERS
            q = _rope((h @ w_q[j]).reshape(B, T, N_KV_HEADS, GROUP, HEAD_DIM), pos)
            out = _window_attention(q, kk, vv, wb, pos0, attn_sinks[j]) @ w_o[j]
        x = x + out
        x = x + 0.5 * _swiglu(_rmsnorm(x, norm_g[l, 2]), ffn_w_gate[l, 1], ffn_w_up[l, 1], ffn_w_down[l, 1])
    y = _rmsnorm(x, final_norm_g)
    return y, jnp.stack(new_pool, axis=0), kk[:, -wb:], vv[:, -wb:]


def setup_inputs(seed: int = 0) -> dict:
    key = jax.random.key(seed)
    ks = jax.random.split(key, 20)
    f32 = jnp.float32
    wb = min(WINDOW, PAST_LEN)
    nrm = lambda k, s, sc: jax.random.normal(k, s, f32) * sc
    return {
        'x_prompt': nrm(ks[0], (BATCH, SEQ, D_MODEL), 1.0),
        'x_sample': nrm(ks[1], (DEC_BATCH, DEC_SEQ, D_MODEL), 1.0),
        'state_pool': nrm(ks[2], (N_A_LAYERS, DEC_BATCH, POOL_BUF, D_MODEL), 1.0),
        'cache_k_win': nrm(ks[3], (DEC_BATCH, wb, N_KV_HEADS, HEAD_DIM), 1.0),
        'cache_v_win': nrm(ks[4], (DEC_BATCH, wb, N_KV_HEADS, HEAD_DIM), 1.0),
        'norm_g': 1.0 + nrm(ks[5], (DEPTH, 3, D_MODEL), 0.05),
        'ffn_w_gate': nrm(ks[6], (DEPTH, 2, D_MODEL, D_FF), D_MODEL ** -0.5),
        'ffn_w_up': nrm(ks[7], (DEPTH, 2, D_MODEL, D_FF), D_MODEL ** -0.5),
        'ffn_w_down': nrm(ks[8], (DEPTH, 2, D_FF, D_MODEL), D_FF ** -0.5),
        'pool_w': nrm(ks[9], (N_A_LAYERS, N_POOL_GROUPS, POOL_GROUP, POOL_GROUP), POOL_GROUP ** -0.5),
        'pool_scale': 1.0 + nrm(ks[10], (N_A_LAYERS, D_MODEL), 0.1),
        'kv_norm_g': 1.0 + nrm(ks[11], (D_MODEL,), 0.05),
        'w_kv': nrm(ks[12], (D_MODEL, 2 * KV_DIM), D_MODEL ** -0.5),
        'w_q': nrm(ks[13], (N_B_LAYERS, D_MODEL, N_HEADS * HEAD_DIM), D_MODEL ** -0.5),
        'w_o': nrm(ks[14], (N_B_LAYERS, N_HEADS * HEAD_DIM, D_MODEL), (N_HEADS * HEAD_DIM) ** -0.5),
        'attn_sinks': nrm(ks[15], (N_B_LAYERS, N_HEADS), 0.5),
        'final_norm_g': 1.0 + nrm(ks[16], (D_MODEL,), 0.05),
    }


def reference(x_prompt, x_sample, state_pool, cache_k_win, cache_v_win, norm_g, ffn_w_gate, ffn_w_up,
              ffn_w_down, pool_w, pool_scale, kv_norm_g, w_kv, w_q, w_o, attn_sinks, final_norm_g):
    Bp = x_prompt.shape[0]
    pool0 = jnp.zeros((N_A_LAYERS, Bp, POOL_BUF, D_MODEL), x_prompt.dtype)
    kbuf0 = jnp.zeros((Bp, WINDOW, N_KV_HEADS, HEAD_DIM), x_prompt.dtype)
    y_prompt, pool_prompt, k_win_prompt, v_win_prompt = _trunk(
        x_prompt, 0, pool0, kbuf0, kbuf0, norm_g, ffn_w_gate, ffn_w_up, ffn_w_down, pool_w,
        pool_scale, kv_norm_g, w_kv, w_q, w_o, attn_sinks, final_norm_g)
    y_sample, pool_sample, k_win_sample, v_win_sample = _trunk(
        x_sample, PAST_LEN, state_pool, cache_k_win, cache_v_win, norm_g, ffn_w_gate, ffn_w_up,
        ffn_w_down, pool_w, pool_scale, kv_norm_g, w_kv, w_q, w_o, attn_sinks, final_norm_g)
    return (y_prompt, y_sample, pool_prompt, pool_sample, k_win_prompt, v_win_prompt, k_win_sample, v_win_sample)
```

```cpp
#include <hip/hip_runtime.h>
#include <hip/hip_cooperative_groups.h>
#include <cstdio>
#include <cstdint>
namespace cg = cooperative_groups;

#ifndef USE_CG_SYNC
#define USE_CG_SYNC 1
#endif

#define LAS __attribute__((address_space(3)))
typedef unsigned short bf16_t;
typedef short bf16x8 __attribute__((ext_vector_type(8)));
typedef float f32x4 __attribute__((ext_vector_type(4)));
typedef float f32x2 __attribute__((ext_vector_type(2)));
typedef unsigned u32x4 __attribute__((ext_vector_type(4)));
typedef unsigned u32x2 __attribute__((ext_vector_type(2)));

constexpr int DM = 1024, DFF = 2816, SEQ = 4096, MPROMPT = 16384, NSAMP = 128, MV = 16512, MP = 16640;
constexpr float LOG2E = 1.4426950408889634f, QSCALE = 0.125f * 1.4426950408889634f, EPS = 1e-5f;
constexpr size_t O_Y = 0, O_POOLP = 16908288, O_POOLS = 16969728, O_KWP = 18935808, O_VWP = 19066880, O_KWS = 19197952, O_VWS = 23392256;
constexpr size_t MiB = 1u << 20;
constexpr size_t WS_CTL = 0, WS_WGU = 1 * MiB, WGU_STRIDE = 12 * MiB, WS_WD = 49 * MiB, WD_STRIDE = 5767168, WS_WPOOL = 71 * MiB, WS_WQ = 72 * MiB, WS_WO = 74 * MiB,
                 WS_XB = 76 * MiB, WS_SSQ = 109 * MiB, WS_TAB = 111 * MiB, WS_KB = 112 * MiB, WS_VT = 121 * MiB, WS_H = 129 * MiB, WS_O = WS_H + 36 * MiB, WS_END = 219 * MiB;
constexpr int LDS_BYTES = 131072 + 1024;

struct Params { const float* in[17]; float* out; unsigned char* ws; };
typedef const __attribute__((address_space(4))) unsigned char* kaptr_t;
struct KA { kaptr_t p;
    __device__ __forceinline__ const float* in(int i) const { return *(const float* const __attribute__((address_space(4)))*)(p + 8 * i); }
    __device__ __forceinline__ float* out() const { return *(float* const __attribute__((address_space(4)))*)(p + 8 * 17); }
    __device__ __forceinline__ unsigned char* ws() const { return *(unsigned char* const __attribute__((address_space(4)))*)(p + 8 * 18); }
};
enum { I_XP = 0, I_XS, I_SPOOL, I_CK, I_CV, I_NORMG, I_WG, I_WU, I_WDN, I_POOLW, I_POOLSC, I_KVG, I_WKV, I_WQ, I_WO, I_SINK, I_FING };

__device__ __forceinline__ unsigned cvt_pk_bf16(float lo, float hi) { unsigned r; asm volatile("v_cvt_pk_bf16_f32 %0, %1, %2" : "=v"(r) : "v"(lo), "v"(hi)); return r; }
__device__ __forceinline__ unsigned f2bf(float f) { unsigned u = __builtin_bit_cast(unsigned, f); return (u + 0x7fffu + ((u >> 16) & 1u)) >> 16; }
__device__ __forceinline__ float bf2f(bf16_t h) { return __builtin_bit_cast(float, (unsigned)h << 16); }
__device__ __forceinline__ u32x2 pack4(f32x4 v) { u32x2 w; w.x = cvt_pk_bf16(v.x, v.y); w.y = cvt_pk_bf16(v.z, v.w); return w; }
__device__ __forceinline__ float wave_sum(float v) {
#pragma unroll
    for (int o = 1; o < 64; o <<= 1) v += __shfl_xor(v, o);
    return v;
}
__device__ __forceinline__ float wave_max(float v) {
#pragma unroll
    for (int o = 1; o < 64; o <<= 1) v = fmaxf(v, __shfl_xor(v, o));
    return v;
}
__device__ __forceinline__ float rdlane(float v, int l) { return __builtin_bit_cast(float, __builtin_amdgcn_readlane(__builtin_bit_cast(int, v), l)); }
__device__ __forceinline__ float rstd_row(const float* ssq, int row) {
    const f32x4* p = (const f32x4*)(ssq + (size_t)row * 16);
    const f32x4 a = p[0], b = p[1], c = p[2], d = p[3];
    const float s = (((a.x + a.y) + (a.z + a.w)) + ((b.x + b.y) + (b.z + b.w))) + (((c.x + c.y) + (c.z + c.w)) + ((d.x + d.y) + (d.z + d.w)));
    return __builtin_amdgcn_rsqf(s * (1.f / 1024.f) + EPS);
}

namespace pg8 {
constexpr int BM = 256, BK = 64, HALF = 128, HTB = HALF * BK * 2, STAGE_BYTES = 8 * HTB, NXCD = 8, WGM = 8;
__host__ __device__ __forceinline__ int lds_byte(int r, int c) { const int st = (r >> 4) * 2 + (c >> 5), rr = r & 15, cc = c & 31, ob = rr * 64 + cc * 2; return st * 1024 + (ob ^ (((ob >> 9) & 1) << 5)); }
__host__ __device__ __forceinline__ void stage_rc(int b, int& R, int& C) { const int st = b / 1024, sb = b % 1024, swz = sb ^ (((sb >> 9) & 1) << 5); R = (st >> 1) * 16 + swz / 64; C = (st & 1) * 32 + (swz % 64) / 2; }

struct Unit { int pm, pn; };
struct Gemm { const bf16_t* A; const bf16_t* Bt; int M, N, K; size_t a_pn_stride;   };

struct StaticOrder {
    int nM, nN, nwg, G, c;
    __device__ void init(int M, int N, int G_, int c_) { nM = M / BM; nN = N / BM; nwg = nM * nN; G = G_; c = c_; }
    __device__ bool next(int i, Unit& u) const {
        const long L = (long)i * G + c; if (L >= nwg) return false;
        int wgid = (int)L; { const int q = nwg / NXCD, r = nwg % NXCD, xcd = wgid % NXCD, off = wgid / NXCD; wgid = (xcd < r ? xcd * (q + 1) : r * (q + 1) + (xcd - r) * q) + off; }
        const int nig = WGM * nN, gid = wgid / nig, fm = gid * WGM, gsz = (nM - fm) < WGM ? (nM - fm) : WGM;
        u.pm = fm + ((wgid % nig) % gsz); u.pn = (wgid % nig) / gsz; return true;
    }
};

template <class Epi>
__device__ __forceinline__ void gemm_phase(LAS unsigned char* lds, const Gemm g, const StaticOrder& S, const Epi& E) {
    const int tid = threadIdx.x, wid = __builtin_amdgcn_readfirstlane(tid >> 6), lane = tid & 63, wr = wid >> 2, wc = wid & 3, fr = lane & 15, fq = lane >> 4;
    const int K = g.K, nt = K / BK;
    unsigned voffA[2], voffB[2];
#pragma unroll
    for (int i = 0; i < 2; ++i) { int R, C; stage_rc(tid * 16 + i * 8192, R, C); voffA[i] = (unsigned)(R * K + C) * 2u; voffB[i] = (unsigned)(R * K + C) * 2u; }
    const size_t kstep = (size_t)(BK * 2);
    const size_t hstep = (size_t)HALF * K * 2;
    const size_t tstep = 2 * hstep;
    const unsigned ldsw = (unsigned)wid * 1024u;
    const int aoff = lds_byte(wr * 64 + fr, fq * 8), boff = lds_byte(wc * 32 + fr, fq * 8);
#define PG8_SA(b, h) (((b) * 2 + (h)) * HTB)
#define PG8_SB(b, h) ((4 + (b) * 2 + (h)) * HTB)
#define PG8_STAGE(bufoff, gbase, voff) do { _Pragma("unroll") for (int _i = 0; _i < 2; ++_i) \
        __builtin_amdgcn_global_load_lds((const unsigned*)((const char*)(gbase) + (voff)[_i]), (LAS unsigned*)(lds + (bufoff) + ldsw + _i * 8192), 16, 0, 0); } while (0)
#define PG8_LDA(dst, b, h) do { _Pragma("unroll") for (int m = 0; m < 4; ++m) _Pragma("unroll") for (int k = 0; k < 2; ++k) dst[m][k] = *(const LAS bf16x8*)(lds + PG8_SA(b, h) + aoff + m * 2048 + k * 1024); } while (0)
#define PG8_LDB(dst, b, h) do { _Pragma("unroll") for (int n = 0; n < 2; ++n) _Pragma("unroll") for (int k = 0; k < 2; ++k) dst[n][k] = *(const LAS bf16x8*)(lds + PG8_SB(b, h) + boff + n * 2048 + k * 1024); } while (0)
#define PG8_MMA(ai, bj, At, Bt) do { __builtin_amdgcn_s_setprio(1); _Pragma("unroll") for (int m = 0; m < 4; ++m) _Pragma("unroll") for (int n = 0; n < 2; ++n) _Pragma("unroll") for (int k = 0; k < 2; ++k) \
        acc[ai][bj][m][n] = __builtin_amdgcn_mfma_f32_16x16x32_bf16(Bt[n][k], At[m][k], acc[ai][bj][m][n], 0, 0, 0); __builtin_amdgcn_s_setprio(0); } while (0)
#define PG8_WAIT_V(n) asm volatile("s_waitcnt vmcnt(" #n ")" ::: "memory")
#define PG8_WAIT_L(n) asm volatile("s_waitcnt lgkmcnt(" #n ")" ::: "memory")
#define PG8_BAR __builtin_amdgcn_s_barrier()
#define PG8_SCHED __builtin_amdgcn_sched_barrier(0)
    Unit cur, nxt; int ui = 0;
    if (!S.next(0, cur)) return;
    f32x4 acc[2][2][4][2];
#pragma unroll
    for (int a = 0; a < 2; ++a)
#pragma unroll
        for (int b = 0; b < 2; ++b)
#pragma unroll
            for (int m = 0; m < 4; ++m)
#pragma unroll
                for (int n = 0; n < 2; ++n) acc[a][b][m][n] = (f32x4){0.f, 0.f, 0.f, 0.f};
    bf16x8 At[4][2], B0[2][2], B1[2][2];
    const char* cA = (const char*)g.A + (size_t)cur.pn * g.a_pn_stride + (size_t)cur.pm * tstep; const char* cB = (const char*)g.Bt + (size_t)cur.pn * tstep;
    PG8_STAGE(PG8_SB(0, 0), cB, voffB); PG8_STAGE(PG8_SB(0, 1), cB + hstep, voffB); PG8_STAGE(PG8_SA(0, 0), cA, voffA); PG8_STAGE(PG8_SA(0, 1), cA + hstep, voffA);
    if (wr == 1) PG8_BAR;
    PG8_WAIT_V(2); PG8_BAR;
    PG8_STAGE(PG8_SB(1, 0), cB + kstep, voffB); PG8_STAGE(PG8_SA(1, 0), cA + kstep, voffA); PG8_STAGE(PG8_SB(1, 1), cB + hstep + kstep, voffB);
    PG8_WAIT_V(6); PG8_BAR;
    for (;;) {
        const bool has_next = S.next(ui + 1, nxt);
        const char* nA = has_next ? (const char*)g.A + (size_t)nxt.pn * g.a_pn_stride + (size_t)nxt.pm * tstep : cA; const char* nB = has_next ? (const char*)g.Bt + (size_t)nxt.pn * tstep : cB;
        for (int t = 0; t < nt; t += 2) {
            const bool last = (t == nt - 2);
            const char* a1 = cA + (size_t)(t + 1) * kstep;
            const char* a2 = last ? nA : cA + (size_t)(t + 2) * kstep; const char* b2 = last ? nB : cB + (size_t)(t + 2) * kstep;
            const char* a3 = a2 + kstep; const char* b3 = b2 + kstep;
            PG8_LDB(B0, 0, 0); PG8_LDB(B1, 0, 1); PG8_SCHED; PG8_LDA(At, 0, 0); PG8_STAGE(PG8_SA(1, 1), a1 + hstep, voffA);
            PG8_WAIT_V(8); PG8_WAIT_L(0); PG8_BAR; PG8_MMA(0, 0, At, B0); PG8_MMA(0, 1, At, B1); PG8_BAR; PG8_SCHED;
            PG8_LDA(At, 0, 1); PG8_STAGE(PG8_SB(0, 0), b2, voffB); PG8_STAGE(PG8_SB(0, 1), b2 + hstep, voffB); PG8_STAGE(PG8_SA(0, 0), a2, voffA);
            PG8_WAIT_V(8); PG8_WAIT_L(0); PG8_BAR; PG8_MMA(1, 0, At, B0); PG8_MMA(1, 1, At, B1); PG8_BAR; PG8_SCHED;
            PG8_LDB(B0, 1, 0); PG8_LDB(B1, 1, 1); PG8_SCHED; PG8_LDA(At, 1, 0); PG8_STAGE(PG8_SA(0, 1), a2 + hstep, voffA);
            PG8_WAIT_V(8); PG8_WAIT_L(0); PG8_BAR; PG8_MMA(0, 0, At, B0); PG8_MMA(0, 1, At, B1); PG8_BAR; PG8_SCHED;
            PG8_LDA(At, 1, 1); PG8_STAGE(PG8_SB(1, 0), b3, voffB); PG8_STAGE(PG8_SB(1, 1), b3 + hstep, voffB); PG8_STAGE(PG8_SA(1, 0), a3, voffA);
            PG8_WAIT_V(8); PG8_WAIT_L(0); PG8_BAR; PG8_MMA(1, 0, At, B0); PG8_MMA(1, 1, At, B1); PG8_BAR; PG8_SCHED;
        }
        if (wr == 0) PG8_BAR;
        E(acc, cur, wr, wc, fr, fq);
        if (!has_next) break;
#pragma unroll
        for (int a = 0; a < 2; ++a)
#pragma unroll
            for (int b = 0; b < 2; ++b)
#pragma unroll
                for (int m = 0; m < 4; ++m)
#pragma unroll
                    for (int n = 0; n < 2; ++n) acc[a][b][m][n] = (f32x4){0.f, 0.f, 0.f, 0.f};
        cur = nxt; cA = nA; cB = nB; ++ui;
        if (wr == 1) PG8_BAR;
    }
    PG8_WAIT_V(0);
    PG8_BAR;
#undef PG8_SA
#undef PG8_SB
#undef PG8_STAGE
#undef PG8_LDA
#undef PG8_LDB
#undef PG8_MMA
#undef PG8_WAIT_V
#undef PG8_WAIT_L
#undef PG8_BAR
#undef PG8_SCHED
}
}

enum { E_SWIGLU = 0, E_RESID = 1, E_Q = 2 };
struct Epi {
    int kind; unsigned char* ws; float* out;
    __device__ __forceinline__ void operator()(const f32x4 (&acc)[2][2][4][2], const pg8::Unit& u, int wr, int wc, int fr, int fq) const {
        float* const X = out; bf16_t* const XB = (bf16_t*)(ws + WS_XB); float* const SSQ = (float*)(ws + WS_SSQ); bf16_t* const H = (bf16_t*)(ws + WS_H); const f32x2* const TAB = (const f32x2*)(ws + WS_TAB);
        bf16_t* const Q = (bf16_t*)(ws + WS_H); bf16_t* const KB = (bf16_t*)(ws + WS_KB); bf16_t* const VT = (bf16_t*)(ws + WS_VT);
        const int nai = (u.pm == 64) ? 1 : 2;
        const int rowt = u.pm * 256 + wr * 64 + fr, colt = wc * 32 + 4 * fq;
        if (kind == E_RESID) {
            _Pragma("unroll") for (int ai = 0; ai < 2; ++ai) if (ai < nai)
#pragma unroll
                for (int m = 0; m < 4; ++m) {
                    const int row = rowt + ai * 128 + m * 16; float ss = 0.f;
                    float* xp = X + (size_t)row * DM + u.pn * 256 + colt; bf16_t* bp = XB + (size_t)row * DM + u.pn * 256 + colt;
#pragma unroll
                    for (int bj = 0; bj < 2; ++bj)
#pragma unroll
                        for (int n = 0; n < 2; ++n) {
                            const f32x4 x = *(const f32x4*)(xp + bj * 128 + n * 16) + acc[ai][bj][m][n];
                            *(f32x4*)(xp + bj * 128 + n * 16) = x; *(u32x2*)(bp + bj * 128 + n * 16) = pack4(x);
                            ss += (x.x * x.x + x.y * x.y) + (x.z * x.z + x.w * x.w);
                        }
                    ss += __shfl_xor(ss, 16); ss += __shfl_xor(ss, 32);
                    if (fq == 0) SSQ[(size_t)row * 16 + u.pn * 4 + wc] = ss;
                }
        } else if (kind == E_Q) {
            _Pragma("unroll") for (int ai = 0; ai < 2; ++ai) if (ai < nai)
#pragma unroll
                for (int m = 0; m < 4; ++m) {
                    const int row = rowt + ai * 128 + m * 16; const float rs = rstd_row(SSQ, row);
                    const int pos = row < MPROMPT ? (row & 4095) : 4096; const f32x2* tb = TAB + pos * 8 + 4 * (fq & 1);
                    bf16_t* qp = Q + (size_t)row * DM + u.pn * 256 + colt;
#pragma unroll
                    for (int bj = 0; bj < 2; ++bj)
#pragma unroll
                        for (int n = 0; n < 2; ++n) {
                            f32x4 v = acc[ai][bj][m][n] * rs;
                            if (n == 0 && (wc & 1) == 0) {
                                f32x4 pr;
#pragma unroll
                                for (int e = 0; e < 4; ++e) pr[e] = __shfl_xor(v[e], 32);
#pragma unroll
                                for (int e = 0; e < 4; ++e) { const f32x2 cs = tb[e]; v[e] = (fq < 2) ? (v[e] * cs.x - pr[e] * cs.y) : (v[e] * cs.x + pr[e] * cs.y); }
                            }
                            *(u32x2*)(qp + bj * 128 + n * 16) = pack4(v);
                        }
                }
        } else if (u.pn < 22) {
            _Pragma("unroll") for (int ai = 0; ai < 2; ++ai) if (ai < nai)
#pragma unroll
                for (int m = 0; m < 4; ++m) {
                    const int row = rowt + ai * 128 + m * 16; const float rs = rstd_row(SSQ, row);
                    bf16_t* hp = H + (size_t)row * DFF + u.pn * 128 + colt;
#pragma unroll
                    for (int n = 0; n < 2; ++n) {
                        const f32x4 gt = acc[ai][0][m][n] * rs, up = acc[ai][1][m][n] * rs; f32x4 hv;
#pragma unroll
                        for (int e = 0; e < 4; ++e) { const float z = gt[e]; hv[e] = z * __builtin_amdgcn_rcpf(1.f + __builtin_amdgcn_exp2f(-z * LOG2E)) * up[e]; }
                        *(u32x2*)(hp + n * 16) = pack4(hv);
                    }
                }
        } else {
            const bool isK = (u.pn == 22);
            _Pragma("unroll") for (int ai = 0; ai < 2; ++ai) if (ai < nai)
#pragma unroll
                for (int m = 0; m < 4; ++m) {
                    const int row = rowt + ai * 128 + m * 16; const float rs = rstd_row(SSQ, row);
                    const bool prompt = row < MPROMPT; const int b = prompt ? (row >> 12) : (row - MPROMPT), t = row & 4095;
                    const int pos = prompt ? t : 4096; const f32x2* tb = TAB + pos * 8 + 4 * (fq & 1);
#pragma unroll
                    for (int bj = 0; bj < 2; ++bj)
#pragma unroll
                        for (int n = 0; n < 2; ++n) {
                            f32x4 v = acc[ai][bj][m][n] * rs; const int col = bj * 128 + colt + n * 16;
                            if (isK) {
                                if (n == 0 && (wc & 1) == 0) {
                                    f32x4 pr;
#pragma unroll
                                    for (int e = 0; e < 4; ++e) pr[e] = __shfl_xor(v[e], 32);
#pragma unroll
                                    for (int e = 0; e < 4; ++e) { const f32x2 cs = tb[e]; v[e] = (fq < 2) ? (v[e] * cs.x - pr[e] * cs.y) : (v[e] * cs.x + pr[e] * cs.y); }
                                }
                                if (prompt) { *(u32x2*)(KB + (size_t)row * 256 + col) = pack4(v);
                                    if (t >= SEQ - 128) *(f32x4*)(out + O_KWP + ((size_t)(b * 128 + t - (SEQ - 128))) * 256 + col) = v; }
                                else *(f32x4*)(out + O_KWS + ((size_t)(b * 128 + 127)) * 256 + col) = v;
                            } else {
                                if (prompt) { bf16_t* vp = VT + ((size_t)(b * 256 + col)) * SEQ + t;
#pragma unroll
                                    for (int e = 0; e < 4; ++e) vp[(size_t)e * SEQ] = (bf16_t)f2bf(v[e]);
                                    if (t >= SEQ - 128) *(f32x4*)(out + O_VWP + ((size_t)(b * 128 + t - (SEQ - 128))) * 256 + col) = v; }
                                else *(f32x4*)(out + O_VWS + ((size_t)(b * 128 + 127)) * 256 + col) = v;
                            }
                        }
                }
        }
    }
};

__device__ __forceinline__ void transpose_item(const float* W, int K, int N, bf16_t* WT, int dst_row0, LAS float* scr, int kb, int nb, int lane,
                                               const float* kscale, const float* nscale, float cs) {
    const int k0 = 64 * kb, n0 = 32 * nb;
    const float ns = cs * (nscale ? nscale[n0 + (lane & 31)] : 1.f);
#pragma unroll 8
    for (int i = 0; i < 32; ++i) { const int kk = 2 * i + (lane >> 5); float v = W[(size_t)(k0 + kk) * N + n0 + (lane & 31)]; if (kscale) v *= kscale[k0 + kk]; scr[kk * 33 + (lane & 31)] = v * ns; }
    asm volatile("s_waitcnt lgkmcnt(0)" ::: "memory");
    const int c = lane & 7;
#pragma unroll
    for (int j = 0; j < 4; ++j) { const int n = (lane >> 3) + 8 * j; const LAS float* s = scr + (8 * c) * 33 + n;
        u32x4 o; o.x = cvt_pk_bf16(s[0 * 33], s[1 * 33]); o.y = cvt_pk_bf16(s[2 * 33], s[3 * 33]); o.z = cvt_pk_bf16(s[4 * 33], s[5 * 33]); o.w = cvt_pk_bf16(s[6 * 33], s[7 * 33]);
        *(u32x4*)(WT + (size_t)(dst_row0 + n) * K + k0 + 8 * c) = o; }
    asm volatile("s_waitcnt lgkmcnt(0)" ::: "memory");
}

__device__ __forceinline__ void prologue(const KA& P, LAS unsigned char* lds, int gw, int NGW, int wave, int lane) {
    unsigned char* ws = P.ws();
    LAS float* scr = (LAS float*)(lds + wave * 16384);
    constexpr int IT_F = 16 * 88, NIT = 12 * IT_F + 128 + 256 + 512 + 512;
    for (int it = gw; it < NIT; it += NGW) {
        int r = it;
        if (r < 8 * IT_F) {
            const int seg = r / IT_F, f = seg & 3, up = seg >> 2; r -= seg * IT_F; const int kb = r / 88, nb = r % 88, n0 = nb * 32;
            const int gi = (f == 0) ? 0 : (f == 1) ? 2 : (f == 2) ? 3 : 5;
            transpose_item(P.in(up ? I_WU : I_WG) + (size_t)f * DM * DFF, DM, DFF, (bf16_t*)(ws + WS_WGU + f * WGU_STRIDE), 256 * (n0 >> 7) + (n0 & 127) + up * 128, scr, kb, nb, lane,
                           P.in(I_NORMG) + gi * DM, nullptr, 1.f);
            continue;
        }
        r -= 8 * IT_F;
        if (r < 4 * IT_F) {
            const int f = r / IT_F; r -= f * IT_F; const int kb = r / 32, nb = r % 32;
            transpose_item(P.in(I_WDN) + (size_t)f * DFF * DM, DFF, DM, (bf16_t*)(ws + WS_WD + f * WD_STRIDE), nb * 32, scr, kb, nb, lane, nullptr, nullptr, 0.5f);
            continue;
        }
        r -= 4 * IT_F;
        if (r < 128) {
            const int g = r >> 5; r &= 31; const int kb = r >> 3, nb = r & 7;
            transpose_item(P.in(I_POOLW) + (size_t)g * 65536, 256, 256, (bf16_t*)(ws + WS_WPOOL), g * 256 + nb * 32, scr, kb, nb, lane, nullptr, P.in(I_POOLSC) + g * 256, 1.f);
            continue;
        }
        r -= 128;
        if (r < 256) { const int kb = r >> 4, nb = r & 15;
            transpose_item(P.in(I_WKV), DM, 512, (bf16_t*)(ws + WS_WGU + 2 * WGU_STRIDE), 5632 + nb * 32, scr, kb, nb, lane, P.in(I_KVG), nullptr, 1.f); continue; }
        r -= 256;
        if (r < 512) { const int kb = r >> 5, nb = r & 31;
            transpose_item(P.in(I_WQ), DM, DM, (bf16_t*)(ws + WS_WQ), nb * 32, scr, kb, nb, lane, P.in(I_NORMG) + 4 * DM, nullptr, QSCALE); continue; }
        r -= 512;
        { const int kb = r >> 5, nb = r & 31; transpose_item(P.in(I_WO), DM, DM, (bf16_t*)(ws + WS_WO), nb * 32, scr, kb, nb, lane, nullptr, nullptr, 1.f); }
    }
    for (int row = gw; row < MV; row += NGW) {
        const float* src = row < MPROMPT ? P.in(I_XP) + (size_t)row * DM : P.in(I_XS) + (size_t)(row - MPROMPT) * DM;
        const f32x4* xr = (const f32x4*)src + lane; f32x4 v[4]; float s = 0.f;
#pragma unroll
        for (int j = 0; j < 4; ++j) { v[j] = xr[64 * j]; s += (v[j].x * v[j].x + v[j].y * v[j].y) + (v[j].z * v[j].z + v[j].w * v[j].w); }
        s = wave_sum(s);
        f32x4* xo = (f32x4*)(P.out() + (size_t)row * DM) + lane; u32x2* bo = (u32x2*)((bf16_t*)(ws + WS_XB) + (size_t)row * DM) + lane;
#pragma unroll
        for (int j = 0; j < 4; ++j) { xo[64 * j] = v[j]; bo[64 * j] = pack4(v[j]); }
        if (lane < 16) ((float*)(ws + WS_SSQ))[(size_t)row * 16 + lane] = (lane == 0) ? s : 0.f;
    }
    {
        const int gt = gw * 64 + lane, NGT = NGW * 64;
        for (int idx = gt; idx < 4097 * 8; idx += NGT) {
            const int pos = idx >> 3, i = idx & 7; const double p = (pos == 4096) ? 16384.0 : (double)pos;
            const double inv = (i == 0) ? 1.0 : (i == 1) ? 0.19392274474868576 : (i == 2) ? 0.03760603093086393 : (i == 3) ? 0.007292664737217109 : (i == 4) ? 0.001414213562373095
                             : (i == 5) ? 0.0002742481756762073 : (i == 6) ? 5.318295896944988e-05 : 1.031338537721246e-05;
            const double rev = p * inv * 0.15915494309189535; const float fr = (float)(rev - __builtin_rint(rev));
            f32x2 cs; cs.x = __builtin_amdgcn_cosf(fr); cs.y = __builtin_amdgcn_sinf(fr);
            ((f32x2*)(ws + WS_TAB))[idx] = cs;
        }
        for (int idx = gt; idx < 2 * 128 * 8128; idx += NGT) {
            const int which = idx / (128 * 8128), r = idx % (128 * 8128), b = r / 8128, q = r % 8128;
            const f32x4* s = (const f32x4*)P.in(which ? I_CV : I_CK) + (size_t)b * 8192 + 64 + q;
            f32x4* d = (f32x4*)(P.out() + (which ? O_VWS : O_KWS)) + (size_t)b * 8192 + q; *d = *s;
        }
    }
}

__device__ __forceinline__ f32x4 pool_h(const float* X, const float* SSQ, int row, int c, f32x4 g4) {
    const float rs = rstd_row(SSQ, row); const f32x4 x = *(const f32x4*)(X + (size_t)row * DM + c); return x * rs * g4;
}
template <int W> __device__ __forceinline__ void pool_run(const KA& P, int b, int t0, int grp, int lane) {
    const float* X = P.out(); const float* SSQ = (const float*)(P.ws() + WS_SSQ); bf16_t* DIFF = (bf16_t*)(P.ws() + WS_H) + (size_t)grp * MP * 256;
    const int c = grp * 256 + 4 * lane; const f32x4 g4 = *(const f32x4*)(P.in(I_NORMG) + 1 * DM + c);
    f32x4 ring[W]; f32x4 s = (f32x4){0.f, 0.f, 0.f, 0.f}; ring[0] = s;
#pragma unroll
    for (int j = 0; j < W - 1; ++j) { const int t = t0 - (W - 1) + j; f32x4 v = (f32x4){0.f, 0.f, 0.f, 0.f}; if (t >= 0) v = pool_h(X, SSQ, b * SEQ + t, c, g4); ring[j + 1] = v; s += v; }
    for (int tt = t0; tt < t0 + 32; tt += W) {
#pragma unroll
        for (int i = 0; i < W; ++i) {
            const int t = tt + i, row = b * SEQ + t; const f32x4 hv = pool_h(X, SSQ, row, c, g4);
            s += hv - ring[i]; ring[i] = hv;
            const float ic = 1.f / (float)((t + 1 < W) ? (t + 1) : W); const f32x4 df = s * ic - hv;
            *(u32x2*)(DIFF + (size_t)row * 256 + 4 * lane) = pack4(df);
            if (t >= SEQ - 15) *(f32x4*)(P.out() + O_POOLP + ((size_t)(b * 15 + t - (SEQ - 15))) * DM + c) = hv;
        }
    }
}
__device__ __forceinline__ void pool_phase(const KA& P, int gw, int NGW, int lane) {
    for (int task = gw; task < 2048 + 512; task += NGW) {
        if (task < 2048) {
            const int grp = task & 3, r = task >> 2, b = r >> 7, t0 = (r & 127) * 32;
            if (grp == 0) pool_run<2>(P, b, t0, 0, lane); else if (grp == 1) pool_run<4>(P, b, t0, 1, lane); else if (grp == 2) pool_run<8>(P, b, t0, 2, lane); else pool_run<16>(P, b, t0, 3, lane);
        } else {
            const int q = task - 2048, grp = q & 3, b = q >> 2, W = 2 << grp, c = grp * 256 + 4 * lane, row = MPROMPT + b;
            const f32x4 g4 = *(const f32x4*)(P.in(I_NORMG) + 1 * DM + c);
            const f32x4 hv = pool_h(P.out(), (const float*)(P.ws() + WS_SSQ), row, c, g4); f32x4 s = hv;
            const float* sp = P.in(I_SPOOL) + (size_t)b * 15 * DM + c;
            for (int j = 1; j < W; ++j) s += *(const f32x4*)(sp + (size_t)(15 - j) * DM);
            const f32x4 df = s * (1.f / (float)W) - hv;
            *(u32x2*)((bf16_t*)(P.ws() + WS_H) + (size_t)grp * MP * 256 + (size_t)row * 256 + 4 * lane) = pack4(df);
            float* po = P.out() + O_POOLS + (size_t)b * 15 * DM + c;
            *(f32x4*)(po + 14 * DM) = hv;
            for (int i = 0; i < 14; ++i) *(f32x4*)(po + (size_t)i * DM) = *(const f32x4*)(sp + (size_t)(i + 1) * DM);
        }
    }
}

__device__ __forceinline__ void attn_prompt_unit(const KA& P, LAS unsigned char* lds, int b, int n, int kvh, int tid, int w, int lane) {
    const bf16_t* KB = (const bf16_t*)(P.ws() + WS_KB); const bf16_t* VT = (const bf16_t*)(P.ws() + WS_VT); const bf16_t* Q = (const bf16_t*)(P.ws() + WS_H); bf16_t* O = (bf16_t*)(P.ws() + WS_O);
    LAS unsigned char* Kt = lds; LAS unsigned char* Vt = lds + 36864;
    const int tk0 = 128 * n - 128;
#pragma unroll
    for (int i = 0; i < 4; ++i) { const int id = tid + 512 * i, row = id >> 3, ch = id & 7, tk = tk0 + row; u32x4 v = (u32x4){0u, 0u, 0u, 0u};
        if (tk >= 0) v = *(const u32x4*)(KB + ((size_t)(b * SEQ + tk)) * 256 + kvh * 64 + ch * 8);
        *(LAS u32x4*)(Kt + row * 144 + ch * 16) = v; }
#pragma unroll
    for (int i = 0; i < 4; ++i) { const int id = tid + 512 * i, d = id >> 5, ch = id & 31, tk = tk0 + 8 * ch; u32x4 v = (u32x4){0u, 0u, 0u, 0u};
        if (tk >= 0) v = *(const u32x4*)(VT + ((size_t)((b * 4 + kvh) * 64 + d)) * SEQ + tk);
        *(LAS u32x4*)(Vt + d * 528 + ch * 16) = v; }
    __syncthreads();
    const int fr = lane & 15, fq = lane >> 4;
    for (int g = 0; g < 4; ++g) {
        const int h = kvh * 4 + g; const size_t qrow = (size_t)b * SEQ + 128 * n + 16 * w + fr;
        bf16x8 qf[2];
#pragma unroll
        for (int ks = 0; ks < 2; ++ks) qf[ks] = *(const bf16x8*)(Q + qrow * DM + h * 64 + 32 * ks + 8 * fq);
        f32x4 s[9];
#pragma unroll
        for (int jj = 0; jj < 9; ++jj) {
            const LAS unsigned char* kp = Kt + (16 * (w + jj) + fr) * 144 + 16 * fq;
            const bf16x8 a0 = *(const LAS bf16x8*)kp, a1 = *(const LAS bf16x8*)(kp + 64);
            f32x4 z = (f32x4){0.f, 0.f, 0.f, 0.f};
            z = __builtin_amdgcn_mfma_f32_16x16x32_bf16(a0, qf[0], z, 0, 0, 0);
            s[jj] = __builtin_amdgcn_mfma_f32_16x16x32_bf16(a1, qf[1], z, 0, 0, 0);
        }
        const float NEG = -1e30f;
#pragma unroll
        for (int jj = 0; jj < 9; ++jj)
#pragma unroll
            for (int i = 0; i < 4; ++i) {
                const int kidx = 4 * fq + i; bool valid = true;
                if (jj == 0) valid = fr < kidx;
                if (jj == 8) valid = fr >= kidx;
                if (n == 0 && (w + jj) < 8) valid = false;
                if (!valid) s[jj][i] = NEG;
            }
        const float sink2 = P.in(I_SINK)[h] * LOG2E;
        float mx = sink2;
#pragma unroll
        for (int jj = 0; jj < 9; ++jj) mx = fmaxf(mx, fmaxf(fmaxf(s[jj][0], s[jj][1]), fmaxf(s[jj][2], s[jj][3])));
        mx = fmaxf(mx, __shfl_xor(mx, 16)); mx = fmaxf(mx, __shfl_xor(mx, 32));
        float sum = 0.f;
#pragma unroll
        for (int jj = 0; jj < 9; ++jj)
#pragma unroll
            for (int i = 0; i < 4; ++i) { const float p = __builtin_amdgcn_exp2f(s[jj][i] - mx); s[jj][i] = p; sum += p; }
        sum += __shfl_xor(sum, 16); sum += __shfl_xor(sum, 32);
        const float inv = 1.f / (sum + __builtin_amdgcn_exp2f(sink2 - mx));
        f32x4 o[4];
#pragma unroll
        for (int db = 0; db < 4; ++db) o[db] = (f32x4){0.f, 0.f, 0.f, 0.f};
#pragma unroll
        for (int s5 = 0; s5 < 5; ++s5) {
            const int j0 = 2 * s5, j1 = 2 * s5 + 1;
            u32x4 pw; pw.x = cvt_pk_bf16(s[j0][0], s[j0][1]); pw.y = cvt_pk_bf16(s[j0][2], s[j0][3]);
            if (j1 < 9) { pw.z = cvt_pk_bf16(s[j1 < 9 ? j1 : 8][0], s[j1 < 9 ? j1 : 8][1]); pw.w = cvt_pk_bf16(s[j1 < 9 ? j1 : 8][2], s[j1 < 9 ? j1 : 8][3]); } else { pw.z = 0u; pw.w = 0u; }
            const bf16x8 pf = __builtin_bit_cast(bf16x8, pw);
            const int jb0 = w + j0; int jb1 = w + j1; if (jb1 > 15) jb1 = 15;
#pragma unroll
            for (int db = 0; db < 4; ++db) {
                const LAS unsigned char* vr = Vt + (16 * db + fr) * 528 + 8 * fq;
                const u32x2 lo = *(const LAS u32x2*)(vr + 32 * jb0), hi = *(const LAS u32x2*)(vr + 32 * jb1);
                u32x4 vw; vw.x = lo.x; vw.y = lo.y; vw.z = hi.x; vw.w = hi.y;
                o[db] = __builtin_amdgcn_mfma_f32_16x16x32_bf16(__builtin_bit_cast(bf16x8, vw), pf, o[db], 0, 0, 0);
            }
        }
#pragma unroll
        for (int db = 0; db < 4; ++db) *(u32x2*)(O + qrow * DM + h * 64 + 16 * db + 4 * fq) = pack4(o[db] * inv);
    }
    __syncthreads();
}
__device__ __forceinline__ void attn_sample_task(const KA& P, int b, int h, int lane) {
    const int kvh = h >> 2;
    const float* kw = P.out() + O_KWS + (size_t)b * 128 * 256 + kvh * 64; const float* vw = P.out() + O_VWS + (size_t)b * 128 * 256 + kvh * 64;
    const bf16_t* Q = (const bf16_t*)(P.ws() + WS_H); bf16_t* O = (bf16_t*)(P.ws() + WS_O);
    const float qd = bf2f(Q[(size_t)(MPROMPT + b) * DM + h * 64 + lane]);
    float s0 = 0.f, s1 = 0.f; const f32x4* k0 = (const f32x4*)(kw + (size_t)lane * 256); const f32x4* k1 = (const f32x4*)(kw + (size_t)(lane + 64) * 256);
#pragma unroll
    for (int c = 0; c < 16; ++c) { const f32x4 a = k0[c], bb = k1[c];
#pragma unroll
        for (int e = 0; e < 4; ++e) { const float q = rdlane(qd, 4 * c + e); s0 += q * a[e]; s1 += q * bb[e]; } }
    const float sink2 = P.in(I_SINK)[h] * LOG2E; const float mx = fmaxf(sink2, wave_max(fmaxf(s0, s1)));
    const float p0 = __builtin_amdgcn_exp2f(s0 - mx), p1 = __builtin_amdgcn_exp2f(s1 - mx); const float l = wave_sum(p0 + p1) + __builtin_amdgcn_exp2f(sink2 - mx);
    float o = 0.f;
#pragma unroll
    for (int i = 0; i < 64; ++i) o += rdlane(p0, i) * vw[(size_t)i * 256 + lane];
#pragma unroll
    for (int i = 0; i < 64; ++i) o += rdlane(p1, i) * vw[(size_t)(64 + i) * 256 + lane];
    O[(size_t)(MPROMPT + b) * DM + h * 64 + lane] = (bf16_t)f2bf(o / l);
}

__global__ void __launch_bounds__(512, 2) yoco_fwd(Params Punused) {
    extern __shared__ __attribute__((aligned(16))) unsigned char lds_raw[];
    LAS unsigned char* lds = (LAS unsigned char*)lds_raw;
    cg::grid_group grid = cg::this_grid();
    const int tid = threadIdx.x, lane = tid & 63, wave = __builtin_amdgcn_readfirstlane(tid >> 6);
    const int G = gridDim.x, gw = blockIdx.x * 8 + wave, NGW = G * 8;
    KA P; P.p = (kaptr_t)__builtin_amdgcn_kernarg_segment_ptr();
#define GRID_BAR() grid.sync()
#define LAUNDER() KA Pl = P; int lane_l = lane, tid_l = tid; asm volatile("" : "+s"(Pl.p)); asm volatile("" : "+v"(lane_l), "+v"(tid_l))

#ifndef NO_PRO
    { LAUNDER(); prologue(Pl, lds, gw, NGW, wave, lane_l); }
#endif
    GRID_BAR();

    for (int ph = 0; ph < 14; ++ph) {
        if (ph == 2) {
#ifndef NO_POOL
            { LAUNDER(); pool_phase(Pl, gw, NGW, lane_l); }
#endif
        }
        else if (ph == 9) {
            LAUNDER();
#ifndef NO_ATTNP
            for (int u = blockIdx.x; u < 512; u += G) { const int kvh = u & 3, n = (u >> 2) & 31, b = u >> 7; attn_prompt_unit(Pl, lds, b, n, kvh, tid_l, wave, lane_l); }
#endif
#ifndef NO_ATTNS
            for (int t = gw; t < 2048; t += NGW) attn_sample_task(Pl, t >> 4, t & 15, lane_l);
#endif
        }
        else if (ph == 13) {
            LAUNDER();
            for (int row = gw; row < MV; row += NGW) {
                const float rs = rstd_row((const float*)(Pl.ws() + WS_SSQ), row); f32x4* xr = (f32x4*)(Pl.out() + (size_t)row * DM) + lane_l; const f32x4* gr = (const f32x4*)Pl.in(I_FING) + lane_l;
#pragma unroll
                for (int j = 0; j < 4; ++j) xr[64 * j] = xr[64 * j] * rs * gr[64 * j];
            }
        }
        else {
            LAUNDER(); unsigned char* ws = Pl.ws();
            pg8::Gemm g; g.M = MP; g.a_pn_stride = 0; Epi E;
            E.ws = ws; E.out = Pl.out();
            const int f = (ph <= 1) ? 0 : (ph <= 5) ? 1 : (ph <= 7) ? 2 : 3;
            if (ph == 0 || ph == 4 || ph == 6 || ph == 11) { g.A = (const bf16_t*)(ws + WS_XB); g.Bt = (const bf16_t*)(ws + WS_WGU + f * WGU_STRIDE); g.N = (ph == 6) ? 6144 : 5632; g.K = DM; E.kind = E_SWIGLU; }
            else if (ph == 1 || ph == 5 || ph == 7 || ph == 12) { g.A = (const bf16_t*)(ws + WS_H); g.Bt = (const bf16_t*)(ws + WS_WD + f * WD_STRIDE); g.N = DM; g.K = DFF; E.kind = E_RESID; }
            else if (ph == 3) { g.A = (const bf16_t*)(ws + WS_H); g.a_pn_stride = (size_t)MP * 256 * 2; g.Bt = (const bf16_t*)(ws + WS_WPOOL); g.N = DM; g.K = 256; E.kind = E_RESID; }
            else if (ph == 8) { g.A = (const bf16_t*)(ws + WS_XB); g.Bt = (const bf16_t*)(ws + WS_WQ); g.N = DM; g.K = DM; E.kind = E_Q; }
            else { g.A = (const bf16_t*)(ws + WS_O); g.Bt = (const bf16_t*)(ws + WS_WO); g.N = DM; g.K = DM; E.kind = E_RESID; }
            pg8::StaticOrder S; S.init(MP, g.N, G, (int)blockIdx.x);
#ifndef NO_GEMM
            pg8::gemm_phase<Epi>(lds, g, S, E);
#endif
        }
        if (ph < 13) GRID_BAR();
    }
}

extern "C" void kernel_launch(void* const* d_in, const int* in_sizes, int n_in, void* d_out, int out_size, void* d_ws, size_t ws_size, hipStream_t stream) {
    static int grid = 0;
    if (grid == 0) {
        int dev = 0, cus = 0, per_cu = 0;
        if (n_in != 17 || ws_size < WS_END) { fprintf(stderr, "kernel_launch: unexpected n_in %d / ws %zu\n", n_in, ws_size); grid = -1; return; }
        hipGetDevice(&dev); hipDeviceGetAttribute(&cus, hipDeviceAttributeMultiprocessorCount, dev);
        if (hipFuncSetAttribute((const void*)yoco_fwd, hipFuncAttributeMaxDynamicSharedMemorySize, LDS_BYTES) != hipSuccess) { fprintf(stderr, "kernel_launch: hipFuncSetAttribute failed\n"); grid = -1; return; }
        if (hipOccupancyMaxActiveBlocksPerMultiprocessor(&per_cu, (const void*)yoco_fwd, 512, LDS_BYTES) != hipSuccess || per_cu < 1) { fprintf(stderr, "kernel_launch: occupancy query says %d\n", per_cu); per_cu = 1; }
        (void)hipGetLastError();
        grid = cus;
    }
    if (grid < 0) return;
    Params p{};
    for (int i = 0; i < 17; ++i) p.in[i] = (const float*)d_in[i];
    p.out = (float*)d_out; p.ws = (unsigned char*)d_ws;
    void* args[] = {&p};
    hipError_t e = hipLaunchCooperativeKernel((const void*)yoco_fwd, dim3(grid), dim3(512), args, LDS_BYTES, stream);
    if (e != hipSuccess) fprintf(stderr, "cooperative launch failed: %s (grid %d)\n", hipGetErrorString(e), grid);
}
```

```cpp
#include <hip/hip_runtime.h>
#include <hip/hip_cooperative_groups.h>
#include <cstdio>
#include <cstdint>
namespace cg = cooperative_groups;

#ifndef USE_CG_SYNC
#define USE_CG_SYNC 1
#endif

#define LAS __attribute__((address_space(3)))
typedef unsigned short bf16_t;
typedef short bf16x8 __attribute__((ext_vector_type(8)));
typedef float f32x4 __attribute__((ext_vector_type(4)));
typedef float f32x2 __attribute__((ext_vector_type(2)));
typedef unsigned u32x4 __attribute__((ext_vector_type(4)));
typedef unsigned u32x2 __attribute__((ext_vector_type(2)));

constexpr int DM = 1024, DFF = 2816, SEQ = 4096, MPROMPT = 16384, NSAMP = 128, MV = 16512, MP = 16640;
constexpr float LOG2E = 1.4426950408889634f, QSCALE = 0.125f * 1.4426950408889634f, EPS = 1e-5f;
constexpr size_t O_Y = 0, O_POOLP = 16908288, O_POOLS = 16969728, O_KWP = 18935808, O_VWP = 19066880, O_KWS = 19197952, O_VWS = 23392256;
constexpr size_t MiB = 1u << 20;
constexpr size_t WS_CTL = 0, WS_WGU = 1 * MiB, WGU_STRIDE = 12 * MiB, WS_WD = 49 * MiB, WD_STRIDE = 5767168, WS_WPOOL = 71 * MiB, WS_WQ = 72 * MiB, WS_WO = 74 * MiB,
                 WS_XB = 76 * MiB, WS_SSQ = 109 * MiB, WS_TAB = 111 * MiB, WS_KB = 112 * MiB, WS_VT = 121 * MiB, WS_H = 129 * MiB, WS_O = WS_H + 36 * MiB, WS_END = 219 * MiB;
constexpr int LDS_BYTES = 131072 + 1024;

struct Params { const float* in[17]; float* out; unsigned char* ws; };
typedef const __attribute__((address_space(4))) unsigned char* kaptr_t;
struct KA { kaptr_t p;
    __device__ __forceinline__ const float* in(int i) const { return *(const float* const __attribute__((address_space(4)))*)(p + 8 * i); }
    __device__ __forceinline__ float* out() const { return *(float* const __attribute__((address_space(4)))*)(p + 8 * 17); }
    __device__ __forceinline__ unsigned char* ws() const { return *(unsigned char* const __attribute__((address_space(4)))*)(p + 8 * 18); }
};
enum { I_XP = 0, I_XS, I_SPOOL, I_CK, I_CV, I_NORMG, I_WG, I_WU, I_WDN, I_POOLW, I_POOLSC, I_KVG, I_WKV, I_WQ, I_WO, I_SINK, I_FING };

__device__ __forceinline__ unsigned cvt_pk_bf16(float lo, float hi) { unsigned r; asm volatile("v_cvt_pk_bf16_f32 %0, %1, %2" : "=v"(r) : "v"(lo), "v"(hi)); return r; }
__device__ __forceinline__ unsigned f2bf(float f) { unsigned u = __builtin_bit_cast(unsigned, f); return (u + 0x7fffu + ((u >> 16) & 1u)) >> 16; }
__device__ __forceinline__ float bf2f(bf16_t h) { return __builtin_bit_cast(float, (unsigned)h << 16); }
__device__ __forceinline__ u32x2 pack4(f32x4 v) { u32x2 w; w.x = cvt_pk_bf16(v.x, v.y); w.y = cvt_pk_bf16(v.z, v.w); return w; }
__device__ __forceinline__ float wave_sum(float v) {
#pragma unroll
    for (int o = 1; o < 64; o <<= 1) v += __shfl_xor(v, o);
    return v;
}
__device__ __forceinline__ float wave_max(float v) {
#pragma unroll
    for (int o = 1; o < 64; o <<= 1) v = fmaxf(v, __shfl_xor(v, o));
    return v;
}
__device__ __forceinline__ float rdlane(float v, int l) { return __builtin_bit_cast(float, __builtin_amdgcn_readlane(__builtin_bit_cast(int, v), l)); }
__device__ __forceinline__ float rstd_row(const float* ssq, int row) {
    const f32x4* p = (const f32x4*)(ssq + (size_t)row * 16);
    const f32x4 a = p[0], b = p[1], c = p[2], d = p[3];
    const float s = (((a.x + a.y) + (a.z + a.w)) + ((b.x + b.y) + (b.z + b.w))) + (((c.x + c.y) + (c.z + c.w)) + ((d.x + d.y) + (d.z + d.w)));
    return __builtin_amdgcn_rsqf(s * (1.f / 1024.f) + EPS);
}

namespace pg8 {
constexpr int BM = 256, BK = 64, HALF = 128, HTB = HALF * BK * 2, STAGE_BYTES = 8 * HTB, NXCD = 8, WGM = 8;
__host__ __device__ __forceinline__ int lds_byte(int r, int c) { const int st = (r >> 4) * 2 + (c >> 5), rr = r & 15, cc = c & 31, ob = rr * 64 + cc * 2; return st * 1024 + (ob ^ (((ob >> 9) & 1) << 5)); }
__host__ __device__ __forceinline__ void stage_rc(int b, int& R, int& C) { const int st = b / 1024, sb = b % 1024, swz = sb ^ (((sb >> 9) & 1) << 5); R = (st >> 1) * 16 + swz / 64; C = (st & 1) * 32 + (swz % 64) / 2; }

struct Unit { int pm, pn; };
struct Gemm { const bf16_t* A; const bf16_t* Bt; int M, N, K; size_t a_pn_stride;   };

struct StaticOrder {
    int nM, nN, nwg, G, c;
    __device__ void init(int M, int N, int G_, int c_) { nM = M / BM; nN = N / BM; nwg = nM * nN; G = G_; c = c_; }
    __device__ bool next(int i, Unit& u) const {
        const long L = (long)i * G + c; if (L >= nwg) return false;
        int wgid = (int)L; { const int q = nwg / NXCD, r = nwg % NXCD, xcd = wgid % NXCD, off = wgid / NXCD; wgid = (xcd < r ? xcd * (q + 1) : r * (q + 1) + (xcd - r) * q) + off; }
        const int nig = WGM * nN, gid = wgid / nig, fm = gid * WGM, gsz = (nM - fm) < WGM ? (nM - fm) : WGM;
        u.pm = fm + ((wgid % nig) % gsz); u.pn = (wgid % nig) / gsz; return true;
    }
};

template <class Epi>
__device__ __forceinline__ void gemm_phase(LAS unsigned char* lds, const Gemm g, const StaticOrder& S, const Epi& E) {
    const int tid = threadIdx.x, wid = __builtin_amdgcn_readfirstlane(tid >> 6), lane = tid & 63, wr = wid >> 2, wc = wid & 3, fr = lane & 15, fq = lane >> 4;
    const int K = g.K, nt = K / BK;
    unsigned voffA[2], voffB[2];
#pragma unroll
    for (int i = 0; i < 2; ++i) { int R, C; stage_rc(tid * 16 + i * 8192, R, C); voffA[i] = (unsigned)(R * K + C) * 2u; voffB[i] = (unsigned)(R * K + C) * 2u; }
    const size_t kstep = (size_t)(BK * 2);
    const size_t hstep = (size_t)HALF * K * 2;
    const size_t tstep = 2 * hstep;
    const unsigned ldsw = (unsigned)wid * 1024u;
    const int aoff = lds_byte(wr * 64 + fr, fq * 8), boff = lds_byte(wc * 32 + fr, fq * 8);
#define PG8_SA(b, h) (((b) * 2 + (h)) * HTB)
#define PG8_SB(b, h) ((4 + (b) * 2 + (h)) * HTB)
#define PG8_STAGE(bufoff, gbase, voff) do { _Pragma("unroll") for (int _i = 0; _i < 2; ++_i) \
        __builtin_amdgcn_global_load_lds((const unsigned*)((const char*)(gbase) + (voff)[_i]), (LAS unsigned*)(lds + (bufoff) + ldsw + _i * 8192), 16, 0, 0); } while (0)
#define PG8_LDA(dst, b, h) do { _Pragma("unroll") for (int m = 0; m < 4; ++m) _Pragma("unroll") for (int k = 0; k < 2; ++k) dst[m][k] = *(const LAS bf16x8*)(lds + PG8_SA(b, h) + aoff + m * 2048 + k * 1024); } while (0)
#define PG8_LDB(dst, b, h) do { _Pragma("unroll") for (int n = 0; n < 2; ++n) _Pragma("unroll") for (int k = 0; k < 2; ++k) dst[n][k] = *(const LAS bf16x8*)(lds + PG8_SB(b, h) + boff + n * 2048 + k * 1024); } while (0)
#define PG8_MMA(ai, bj, At, Bt) do { __builtin_amdgcn_s_setprio(1); _Pragma("unroll") for (int m = 0; m < 4; ++m) _Pragma("unroll") for (int n = 0; n < 2; ++n) _Pragma("unroll") for (int k = 0; k < 2; ++k) \
        acc[ai][bj][m][n] = __builtin_amdgcn_mfma_f32_16x16x32_bf16(Bt[n][k], At[m][k], acc[ai][bj][m][n], 0, 0, 0); __builtin_amdgcn_s_setprio(0); } while (0)
#define PG8_WAIT_V(n) asm volatile("s_waitcnt vmcnt(" #n ")" ::: "memory")
#define PG8_WAIT_L(n) asm volatile("s_waitcnt lgkmcnt(" #n ")" ::: "memory")
#define PG8_BAR __builtin_amdgcn_s_barrier()
#define PG8_SCHED __builtin_amdgcn_sched_barrier(0)
    Unit cur, nxt; int ui = 0;
    if (!S.next(0, cur)) return;
    f32x4 acc[2][2][4][2];
#pragma unroll
    for (int a = 0; a < 2; ++a)
#pragma unroll
        for (int b = 0; b < 2; ++b)
#pragma unroll
            for (int m = 0; m < 4; ++m)
#pragma unroll
                for (int n = 0; n < 2; ++n) acc[a][b][m][n] = (f32x4){0.f, 0.f, 0.f, 0.f};
    bf16x8 At[4][2], B0[2][2], B1[2][2];
    const char* cA = (const char*)g.A + (size_t)cur.pn * g.a_pn_stride + (size_t)cur.pm * tstep; const char* cB = (const char*)g.Bt + (size_t)cur.pn * tstep;
    PG8_STAGE(PG8_SB(0, 0), cB, voffB); PG8_STAGE(PG8_SB(0, 1), cB + hstep, voffB); PG8_STAGE(PG8_SA(0, 0), cA, voffA); PG8_STAGE(PG8_SA(0, 1), cA + hstep, voffA);
    if (wr == 1) PG8_BAR;
    PG8_WAIT_V(2); PG8_BAR;
    PG8_STAGE(PG8_SB(1, 0), cB + kstep, voffB); PG8_STAGE(PG8_SA(1, 0), cA + kstep, voffA); PG8_STAGE(PG8_SB(1, 1), cB + hstep + kstep, voffB);
    PG8_WAIT_V(6); PG8_BAR;
    for (;;) {
        const bool has_next = S.next(ui + 1, nxt);
        const char* nA = has_next ? (const char*)g.A + (size_t)nxt.pn * g.a_pn_stride + (size_t)nxt.pm * tstep : cA; const char* nB = has_next ? (const char*)g.Bt + (size_t)nxt.pn * tstep : cB;
        for (int t = 0; t < nt; t += 2) {
            const bool last = (t == nt - 2);
            const char* a1 = cA + (size_t)(t + 1) * kstep;
            const char* a2 = last ? nA : cA + (size_t)(t + 2) * kstep; const char* b2 = last ? nB : cB + (size_t)(t + 2) * kstep;
            const char* a3 = a2 + kstep; const char* b3 = b2 + kstep;
            PG8_LDB(B0, 0, 0); PG8_LDB(B1, 0, 1); PG8_SCHED; PG8_LDA(At, 0, 0); PG8_STAGE(PG8_SA(1, 1), a1 + hstep, voffA);
            PG8_WAIT_V(8); PG8_WAIT_L(0); PG8_BAR; PG8_MMA(0, 0, At, B0); PG8_MMA(0, 1, At, B1); PG8_BAR; PG8_SCHED;
            PG8_LDA(At, 0, 1); PG8_STAGE(PG8_SB(0, 0), b2, voffB); PG8_STAGE(PG8_SB(0, 1), b2 + hstep, voffB); PG8_STAGE(PG8_SA(0, 0), a2, voffA);
            PG8_WAIT_V(8); PG8_WAIT_L(0); PG8_BAR; PG8_MMA(1, 0, At, B0); PG8_MMA(1, 1, At, B1); PG8_BAR; PG8_SCHED;
            PG8_LDB(B0, 1, 0); PG8_LDB(B1, 1, 1); PG8_SCHED; PG8_LDA(At, 1, 0); PG8_STAGE(PG8_SA(0, 1), a2 + hstep, voffA);
            PG8_WAIT_V(8); PG8_WAIT_L(0); PG8_BAR; PG8_MMA(0, 0, At, B0); PG8_MMA(0, 1, At, B1); PG8_BAR; PG8_SCHED;
            PG8_LDA(At, 1, 1); PG8_STAGE(PG8_SB(1, 0), b3, voffB); PG8_STAGE(PG8_SB(1, 1), b3 + hstep, voffB); PG8_STAGE(PG8_SA(1, 0), a3, voffA);
            PG8_WAIT_V(8); PG8_WAIT_L(0); PG8_BAR; PG8_MMA(1, 0, At, B0); PG8_MMA(1, 1, At, B1); PG8_BAR; PG8_SCHED;
        }
        if (wr == 0) PG8_BAR;
        E(acc, cur, wr, wc, fr, fq);
        if (!has_next) break;
#pragma unroll
        for (int a = 0; a < 2; ++a)
#pragma unroll
            for (int b = 0; b < 2; ++b)
#pragma unroll
                for (int m = 0; m < 4; ++m)
#pragma unroll
                    for (int n = 0; n < 2; ++n) acc[a][b][m][n] = (f32x4){0.f, 0.f, 0.f, 0.f};
        cur = nxt; cA = nA; cB = nB; ++ui;
        if (wr == 1) PG8_BAR;
    }
    PG8_WAIT_V(0);
    PG8_BAR;
#undef PG8_SA
#undef PG8_SB
#undef PG8_STAGE
#undef PG8_LDA
#undef PG8_LDB
#undef PG8_MMA
#undef PG8_WAIT_V
#undef PG8_WAIT_L
#undef PG8_BAR
#undef PG8_SCHED
}
}

enum { E_SWIGLU = 0, E_RESID = 1, E_Q = 2 };
struct Epi {
    int kind; unsigned char* ws; float* out;
    __device__ __forceinline__ void operator()(const f32x4 (&acc)[2][2][4][2], const pg8::Unit& u, int wr, int wc, int fr, int fq) const {
        float* const X = out; bf16_t* const XB = (bf16_t*)(ws + WS_XB); float* const SSQ = (float*)(ws + WS_SSQ); bf16_t* const H = (bf16_t*)(ws + WS_H); const f32x2* const TAB = (const f32x2*)(ws + WS_TAB);
        bf16_t* const Q = (bf16_t*)(ws + WS_H); bf16_t* const KB = (bf16_t*)(ws + WS_KB); bf16_t* const VT = (bf16_t*)(ws + WS_VT);
        const int nai = (u.pm == 64) ? 1 : 2;
        const int rowt = u.pm * 256 + wr * 64 + fr, colt = wc * 32 + 4 * fq;
        if (kind == E_RESID) {
            _Pragma("unroll") for (int ai = 0; ai < 2; ++ai) if (ai < nai)
#pragma unroll
                for (int m = 0; m < 4; ++m) {
                    const int row = rowt + ai * 128 + m * 16; float ss = 0.f;
                    float* xp = X + (size_t)row * DM + u.pn * 256 + colt; bf16_t* bp = XB + (size_t)row * DM + u.pn * 256 + colt;
#pragma unroll
                    for (int bj = 0; bj < 2; ++bj)
#pragma unroll
                        for (int n = 0; n < 2; ++n) {
                            const f32x4 x = *(const f32x4*)(xp + bj * 128 + n * 16) + acc[ai][bj][m][n];
                            *(f32x4*)(xp + bj * 128 + n * 16) = x; *(u32x2*)(bp + bj * 128 + n * 16) = pack4(x);
                            ss += (x.x * x.x + x.y * x.y) + (x.z * x.z + x.w * x.w);
                        }
                    ss += __shfl_xor(ss, 16); ss += __shfl_xor(ss, 32);
                    if (fq == 0) SSQ[(size_t)row * 16 + u.pn * 4 + wc] = ss;
                }
        } else if (kind == E_Q) {
            _Pragma("unroll") for (int ai = 0; ai < 2; ++ai) if (ai < nai)
#pragma unroll
                for (int m = 0; m < 4; ++m) {
                    const int row = rowt + ai * 128 + m * 16; const float rs = rstd_row(SSQ, row);
                    const int pos = row < MPROMPT ? (row & 4095) : 4096; const f32x2* tb = TAB + pos * 8 + 4 * (fq & 1);
                    bf16_t* qp = Q + (size_t)row * DM + u.pn * 256 + colt;
#pragma unroll
                    for (int bj = 0; bj < 2; ++bj)
#pragma unroll
                        for (int n = 0; n < 2; ++n) {
                            f32x4 v = acc[ai][bj][m][n] * rs;
                            if (n == 0 && (wc & 1) == 0) {
                                f32x4 pr;
#pragma unroll
                                for (int e = 0; e < 4; ++e) pr[e] = __shfl_xor(v[e], 32);
#pragma unroll
                                for (int e = 0; e < 4; ++e) { const f32x2 cs = tb[e]; v[e] = (fq < 2) ? (v[e] * cs.x - pr[e] * cs.y) : (v[e] * cs.x + pr[e] * cs.y); }
                            }
                            *(u32x2*)(qp + bj * 128 + n * 16) = pack4(v);
                        }
                }
        } else if (u.pn < 22) {
            _Pragma("unroll") for (int ai = 0; ai < 2; ++ai) if (ai < nai)
#pragma unroll
                for (int m = 0; m < 4; ++m) {
                    const int row = rowt + ai * 128 + m * 16; const float rs = rstd_row(SSQ, row);
                    bf16_t* hp = H + (size_t)row * DFF + u.pn * 128 + colt;
#pragma unroll
                    for (int n = 0; n < 2; ++n) {
                        const f32x4 gt = acc[ai][0][m][n] * rs, up = acc[ai][1][m][n] * rs; f32x4 hv;
#pragma unroll
                        for (int e = 0; e < 4; ++e) { const float z = gt[e]; hv[e] = z * __builtin_amdgcn_rcpf(1.f + __builtin_amdgcn_exp2f(-z * LOG2E)) * up[e]; }
                        *(u32x2*)(hp + n * 16) = pack4(hv);
                    }
                }
        } else {
            const bool isK = (u.pn == 22);
            _Pragma("unroll") for (int ai = 0; ai < 2; ++ai) if (ai < nai)
#pragma unroll
                for (int m = 0; m < 4; ++m) {
                    const int row = rowt + ai * 128 + m * 16; const float rs = rstd_row(SSQ, row);
                    const bool prompt = row < MPROMPT; const int b = prompt ? (row >> 12) : (row - MPROMPT), t = row & 4095;
                    const int pos = prompt ? t : 4096; const f32x2* tb = TAB + pos * 8 + 4 * (fq & 1);
#pragma unroll
                    for (int bj = 0; bj < 2; ++bj)
#pragma unroll
                        for (int n = 0; n < 2; ++n) {
                            f32x4 v = acc[ai][bj][m][n] * rs; const int col = bj * 128 + colt + n * 16;
                            if (isK) {
                                if (n == 0 && (wc & 1) == 0) {
                                    f32x4 pr;
#pragma unroll
                                    for (int e = 0; e < 4; ++e) pr[e] = __shfl_xor(v[e], 32);
#pragma unroll
                                    for (int e = 0; e < 4; ++e) { const f32x2 cs = tb[e]; v[e] = (fq < 2) ? (v[e] * cs.x - pr[e] * cs.y) : (v[e] * cs.x + pr[e] * cs.y); }
                                }
                                if (prompt) { *(u32x2*)(KB + (size_t)row * 256 + col) = pack4(v);
                                    if (t >= SEQ - 128) *(f32x4*)(out + O_KWP + ((size_t)(b * 128 + t - (SEQ - 128))) * 256 + col) = v; }
                                else *(f32x4*)(out + O_KWS + ((size_t)(b * 128 + 127)) * 256 + col) = v;
                            } else {
                                if (prompt) { bf16_t* vp = VT + ((size_t)(b * 256 + col)) * SEQ + t;
#pragma unroll
                                    for (int e = 0; e < 4; ++e) vp[(size_t)e * SEQ] = (bf16_t)f2bf(v[e]);
                                    if (t >= SEQ - 128) *(f32x4*)(out + O_VWP + ((size_t)(b * 128 + t - (SEQ - 128))) * 256 + col) = v; }
                                else *(f32x4*)(out + O_VWS + ((size_t)(b * 128 + 127)) * 256 + col) = v;
                            }
                        }
                }
        }
    }
};

__device__ __forceinline__ void transpose_item(const float* W, int K, int N, bf16_t* WT, int dst_row0, LAS float* scr, int kb, int nb, int lane,
                                               const float* kscale, const float* nscale, float cs) {
    const int k0 = 64 * kb, n0 = 32 * nb;
    const float ns = cs * (nscale ? nscale[n0 + (lane & 31)] : 1.f);
#pragma unroll 8
    for (int i = 0; i < 32; ++i) { const int kk = 2 * i + (lane >> 5); float v = W[(size_t)(k0 + kk) * N + n0 + (lane & 31)]; if (kscale) v *= kscale[k0 + kk]; scr[kk * 33 + (lane & 31)] = v * ns; }
    asm volatile("s_waitcnt lgkmcnt(0)" ::: "memory");
    const int c = lane & 7;
#pragma unroll
    for (int j = 0; j < 4; ++j) { const int n = (lane >> 3) + 8 * j; const LAS float* s = scr + (8 * c) * 33 + n;
        u32x4 o; o.x = cvt_pk_bf16(s[0 * 33], s[1 * 33]); o.y = cvt_pk_bf16(s[2 * 33], s[3 * 33]); o.z = cvt_pk_bf16(s[4 * 33], s[5 * 33]); o.w = cvt_pk_bf16(s[6 * 33], s[7 * 33]);
        *(u32x4*)(WT + (size_t)(dst_row0 + n) * K + k0 + 8 * c) = o; }
    asm volatile("s_waitcnt lgkmcnt(0)" ::: "memory");
}

__device__ __forceinline__ void prologue(const KA& P, LAS unsigned char* lds, int gw, int NGW, int wave, int lane) {
    unsigned char* ws = P.ws();
    LAS float* scr = (LAS float*)(lds + wave * 16384);
    constexpr int IT_F = 16 * 88, NIT = 12 * IT_F + 128 + 256 + 512 + 512;
    for (int it = gw; it < NIT; it += NGW) {
        int r = it;
        if (r < 8 * IT_F) {
            const int seg = r / IT_F, f = seg & 3, up = seg >> 2; r -= seg * IT_F; const int kb = r / 88, nb = r % 88, n0 = nb * 32;
            const int gi = (f == 0) ? 0 : (f == 1) ? 2 : (f == 2) ? 3 : 5;
            transpose_item(P.in(up ? I_WU : I_WG) + (size_t)f * DM * DFF, DM, DFF, (bf16_t*)(ws + WS_WGU + f * WGU_STRIDE), 256 * (n0 >> 7) + (n0 & 127) + up * 128, scr, kb, nb, lane,
                           P.in(I_NORMG) + gi * DM, nullptr, 1.f);
            continue;
        }
        r -= 8 * IT_F;
        if (r < 4 * IT_F) {
            const int f = r / IT_F; r -= f * IT_F; const int kb = r / 32, nb = r % 32;
            transpose_item(P.in(I_WDN) + (size_t)f * DFF * DM, DFF, DM, (bf16_t*)(ws + WS_WD + f * WD_STRIDE), nb * 32, scr, kb, nb, lane, nullptr, nullptr, 0.5f);
            continue;
        }
        r -= 4 * IT_F;
        if (r < 128) {
            const int g = r >> 5; r &= 31; const int kb = r >> 3, nb = r & 7;
            transpose_item(P.in(I_POOLW) + (size_t)g * 65536, 256, 256, (bf16_t*)(ws + WS_WPOOL), g * 256 + nb * 32, scr, kb, nb, lane, nullptr, P.in(I_POOLSC) + g * 256, 1.f);
            continue;
        }
        r -= 128;
        if (r < 256) { const int kb = r >> 4, nb = r & 15;
            transpose_item(P.in(I_WKV), DM, 512, (bf16_t*)(ws + WS_WGU + 2 * WGU_STRIDE), 5632 + nb * 32, scr, kb, nb, lane, P.in(I_KVG), nullptr, 1.f); continue; }
        r -= 256;
        if (r < 512) { const int kb = r >> 5, nb = r & 31;
            transpose_item(P.in(I_WQ), DM, DM, (bf16_t*)(ws + WS_WQ), nb * 32, scr, kb, nb, lane, P.in(I_NORMG) + 4 * DM, nullptr, QSCALE); continue; }
        r -= 512;
        { const int kb = r >> 5, nb = r & 31; transpose_item(P.in(I_WO), DM, DM, (bf16_t*)(ws + WS_WO), nb * 32, scr, kb, nb, lane, nullptr, nullptr, 1.f); }
    }
    for (int row = gw; row < MV; row += NGW) {
        const float* src = row < MPROMPT ? P.in(I_XP) + (size_t)row * DM : P.in(I_XS) + (size_t)(row - MPROMPT) * DM;
        const f32x4* xr = (const f32x4*)src + lane; f32x4 v[4]; float s = 0.f;
#pragma unroll
        for (int j = 0; j < 4; ++j) { v[j] = xr[64 * j]; s += (v[j].x * v[j].x + v[j].y * v[j].y) + (v[j].z * v[j].z + v[j].w * v[j].w); }
        s = wave_sum(s);
        f32x4* xo = (f32x4*)(P.out() + (size_t)row * DM) + lane; u32x2* bo = (u32x2*)((bf16_t*)(ws + WS_XB) + (size_t)row * DM) + lane;
#pragma unroll
        for (int j = 0; j < 4; ++j) { xo[64 * j] = v[j]; bo[64 * j] = pack4(v[j]); }
        if (lane < 16) ((float*)(ws + WS_SSQ))[(size_t)row * 16 + lane] = (lane == 0) ? s : 0.f;
    }
    {
        const int gt = gw * 64 + lane, NGT = NGW * 64;
        for (int idx = gt; idx < 4097 * 8; idx += NGT) {
            const int pos = idx >> 3, i = idx & 7; const double p = (pos == 4096) ? 16384.0 : (double)pos;
            const double inv = (i == 0) ? 1.0 : (i == 1) ? 0.19392274474868576 : (i == 2) ? 0.03760603093086393 : (i == 3) ? 0.007292664737217109 : (i == 4) ? 0.001414213562373095
                             : (i == 5) ? 0.0002742481756762073 : (i == 6) ? 5.318295896944988e-05 : 1.031338537721246e-05;
            const double rev = p * inv * 0.15915494309189535; const float fr = (float)(rev - __builtin_rint(rev));
            f32x2 cs; cs.x = __builtin_amdgcn_cosf(fr); cs.y = __builtin_amdgcn_sinf(fr);
            ((f32x2*)(ws + WS_TAB))[idx] = cs;
        }
        for (int idx = gt; idx < 2 * 128 * 8128; idx += NGT) {
            const int which = idx / (128 * 8128), r = idx % (128 * 8128), b = r / 8128, q = r % 8128;
            const f32x4* s = (const f32x4*)P.in(which ? I_CV : I_CK) + (size_t)b * 8192 + 64 + q;
            f32x4* d = (f32x4*)(P.out() + (which ? O_VWS : O_KWS)) + (size_t)b * 8192 + q; *d = *s;
        }
    }
}

__device__ __forceinline__ f32x4 pool_h(const float* X, const float* SSQ, int row, int c, f32x4 g4) {
    const float rs = rstd_row(SSQ, row); const f32x4 x = *(const f32x4*)(X + (size_t)row * DM + c); return x * rs * g4;
}
template <int W> __device__ __forceinline__ void pool_run(const KA& P, int b, int t0, int grp, int lane) {
    const float* X = P.out(); const float* SSQ = (const float*)(P.ws() + WS_SSQ); bf16_t* DIFF = (bf16_t*)(P.ws() + WS_H) + (size_t)grp * MP * 256;
    const int c = grp * 256 + 4 * lane; const f32x4 g4 = *(const f32x4*)(P.in(I_NORMG) + 1 * DM + c);
    f32x4 ring[W]; f32x4 s = (f32x4){0.f, 0.f, 0.f, 0.f}; ring[0] = s;
#pragma unroll
    for (int j = 0; j < W - 1; ++j) { const int t = t0 - (W - 1) + j; f32x4 v = (f32x4){0.f, 0.f, 0.f, 0.f}; if (t >= 0) v = pool_h(X, SSQ, b * SEQ + t, c, g4); ring[j + 1] = v; s += v; }
    for (int tt = t0; tt < t0 + 32; tt += W) {
#pragma unroll
        for (int i = 0; i < W; ++i) {
            const int t = tt + i, row = b * SEQ + t; const f32x4 hv = pool_h(X, SSQ, row, c, g4);
            s += hv - ring[i]; ring[i] = hv;
            const float ic = 1.f / (float)((t + 1 < W) ? (t + 1) : W); const f32x4 df = s * ic - hv;
            *(u32x2*)(DIFF + (size_t)row * 256 + 4 * lane) = pack4(df);
            if (t >= SEQ - 15) *(f32x4*)(P.out() + O_POOLP + ((size_t)(b * 15 + t - (SEQ - 15))) * DM + c) = hv;
        }
    }
}
__device__ __forceinline__ void pool_phase(const KA& P, int gw, int NGW, int lane) {
    for (int task = gw; task < 2048 + 512; task += NGW) {
        if (task < 2048) {
            const int grp = task & 3, r = task >> 2, b = r >> 7, t0 = (r & 127) * 32;
            if (grp == 0) pool_run<2>(P, b, t0, 0, lane); else if (grp == 1) pool_run<4>(P, b, t0, 1, lane); else if (grp == 2) pool_run<8>(P, b, t0, 2, lane); else pool_run<16>(P, b, t0, 3, lane);
        } else {
            const int q = task - 2048, grp = q & 3, b = q >> 2, W = 2 << grp, c = grp * 256 + 4 * lane, row = MPROMPT + b;
            const f32x4 g4 = *(const f32x4*)(P.in(I_NORMG) + 1 * DM + c);
            const f32x4 hv = pool_h(P.out(), (const float*)(P.ws() + WS_SSQ), row, c, g4); f32x4 s = hv;
            const float* sp = P.in(I_SPOOL) + (size_t)b * 15 * DM + c;
            for (int j = 1; j < W; ++j) s += *(const f32x4*)(sp + (size_t)(15 - j) * DM);
            const f32x4 df = s * (1.f / (float)W) - hv;
            *(u32x2*)((bf16_t*)(P.ws() + WS_H) + (size_t)grp * MP * 256 + (size_t)row * 256 + 4 * lane) = pack4(df);
            float* po = P.out() + O_POOLS + (size_t)b * 15 * DM + c;
            *(f32x4*)(po + 14 * DM) = hv;
            for (int i = 0; i < 14; ++i) *(f32x4*)(po + (size_t)i * DM) = *(const f32x4*)(sp + (size_t)(i + 1) * DM);
        }
    }
}

__device__ __forceinline__ void attn_prompt_unit(const KA& P, LAS unsigned char* lds, int b, int n, int kvh, int tid, int w, int lane) {
    const bf16_t* KB = (const bf16_t*)(P.ws() + WS_KB); const bf16_t* VT = (const bf16_t*)(P.ws() + WS_VT); const bf16_t* Q = (const bf16_t*)(P.ws() + WS_H); bf16_t* O = (bf16_t*)(P.ws() + WS_O);
    LAS unsigned char* Kt = lds; LAS unsigned char* Vt = lds + 36864;
    const int tk0 = 128 * n - 128;
#pragma unroll
    for (int i = 0; i < 4; ++i) { const int id = tid + 512 * i, row = id >> 3, ch = id & 7, tk = tk0 + row; u32x4 v = (u32x4){0u, 0u, 0u, 0u};
        if (tk >= 0) v = *(const u32x4*)(KB + ((size_t)(b * SEQ + tk)) * 256 + kvh * 64 + ch * 8);
        *(LAS u32x4*)(Kt + row * 144 + ch * 16) = v; }
#pragma unroll
    for (int i = 0; i < 4; ++i) { const int id = tid + 512 * i, d = id >> 5, ch = id & 31, tk = tk0 + 8 * ch; u32x4 v = (u32x4){0u, 0u, 0u, 0u};
        if (tk >= 0) v = *(const u32x4*)(VT + ((size_t)((b * 4 + kvh) * 64 + d)) * SEQ + tk);
        *(LAS u32x4*)(Vt + d * 528 + ch * 16) = v; }
    __syncthreads();
    const int fr = lane & 15, fq = lane >> 4;
    for (int g = 0; g < 4; ++g) {
        const int h = kvh * 4 + g; const size_t qrow = (size_t)b * SEQ + 128 * n + 16 * w + fr;
        bf16x8 qf[2];
#pragma unroll
        for (int ks = 0; ks < 2; ++ks) qf[ks] = *(const bf16x8*)(Q + qrow * DM + h * 64 + 32 * ks + 8 * fq);
        f32x4 s[9];
#pragma unroll
        for (int jj = 0; jj < 9; ++jj) {
            const LAS unsigned char* kp = Kt + (16 * (w + jj) + fr) * 144 + 16 * fq;
            const bf16x8 a0 = *(const LAS bf16x8*)kp, a1 = *(const LAS bf16x8*)(kp + 64);
            f32x4 z = (f32x4){0.f, 0.f, 0.f, 0.f};
            z = __builtin_amdgcn_mfma_f32_16x16x32_bf16(a0, qf[0], z, 0, 0, 0);
            s[jj] = __builtin_amdgcn_mfma_f32_16x16x32_bf16(a1, qf[1], z, 0, 0, 0);
        }
        const float NEG = -1e30f;
#pragma unroll
        for (int jj = 0; jj < 9; ++jj)
#pragma unroll
            for (int i = 0; i < 4; ++i) {
                const int kidx = 4 * fq + i; bool valid = true;
                if (jj == 0) valid = fr < kidx;
                if (jj == 8) valid = fr >= kidx;
                if (n == 0 && (w + jj) < 8) valid = false;
                if (!valid) s[jj][i] = NEG;
            }
        const float sink2 = P.in(I_SINK)[h] * LOG2E;
        float mx = sink2;
#pragma unroll
        for (int jj = 0; jj < 9; ++jj) mx = fmaxf(mx, fmaxf(fmaxf(s[jj][0], s[jj][1]), fmaxf(s[jj][2], s[jj][3])));
        mx = fmaxf(mx, __shfl_xor(mx, 16)); mx = fmaxf(mx, __shfl_xor(mx, 32));
        float sum = 0.f;
#pragma unroll
        for (int jj = 0; jj < 9; ++jj)
#pragma unroll
            for (int i = 0; i < 4; ++i) { const float p = __builtin_amdgcn_exp2f(s[jj][i] - mx); s[jj][i] = p; sum += p; }
        sum += __shfl_xor(sum, 16); sum += __shfl_xor(sum, 32);
        const float inv = 1.f / (sum + __builtin_amdgcn_exp2f(sink2 - mx));
        f32x4 o[4];
#pragma unroll
        for (int db = 0; db < 4; ++db) o[db] = (f32x4){0.f, 0.f, 0.f, 0.f};
#pragma unroll
        for (int s5 = 0; s5 < 5; ++s5) {
            const int j0 = 2 * s5, j1 = 2 * s5 + 1;
            u32x4 pw; pw.x = cvt_pk_bf16(s[j0][0], s[j0][1]); pw.y = cvt_pk_bf16(s[j0][2], s[j0][3]);
            if (j1 < 9) { pw.z = cvt_pk_bf16(s[j1 < 9 ? j1 : 8][0], s[j1 < 9 ? j1 : 8][1]); pw.w = cvt_pk_bf16(s[j1 < 9 ? j1 : 8][2], s[j1 < 9 ? j1 : 8][3]); } else { pw.z = 0u; pw.w = 0u; }
            const bf16x8 pf = __builtin_bit_cast(bf16x8, pw);
            const int jb0 = w + j0; int jb1 = w + j1; if (jb1 > 15) jb1 = 15;
#pragma unroll
            for (int db = 0; db < 4; ++db) {
                const LAS unsigned char* vr = Vt + (16 * db + fr) * 528 + 8 * fq;
                const u32x2 lo = *(const LAS u32x2*)(vr + 32 * jb0), hi = *(const LAS u32x2*)(vr + 32 * jb1);
                u32x4 vw; vw.x = lo.x; vw.y = lo.y; vw.z = hi.x; vw.w = hi.y;
                o[db] = __builtin_amdgcn_mfma_f32_16x16x32_bf16(__builtin_bit_cast(bf16x8, vw), pf, o[db], 0, 0, 0);
            }
        }
#pragma unroll
        for (int db = 0; db < 4; ++db) *(u32x2*)(O + qrow * DM + h * 64 + 16 * db + 4 * fq) = pack4(o[db] * inv);
    }
    __syncthreads();
}
__device__ __forceinline__ void attn_sample_task(const KA& P, int b, int h, int lane) {
    const int kvh = h >> 2;
    const float* kw = P.out() + O_KWS + (size_t)b * 128 * 256 + kvh * 64; const float* vw = P.out() + O_VWS + (size_t)b * 128 * 256 + kvh * 64;
    const bf16_t* Q = (const bf16_t*)(P.ws() + WS_H); bf16_t* O = (bf16_t*)(P.ws() + WS_O);
    const float qd = bf2f(Q[(size_t)(MPROMPT + b) * DM + h * 64 + lane]);
    float s0 = 0.f, s1 = 0.f; const f32x4* k0 = (const f32x4*)(kw + (size_t)lane * 256); const f32x4* k1 = (const f32x4*)(kw + (size_t)(lane + 64) * 256);
#pragma unroll
    for (int c = 0; c < 16; ++c) { const f32x4 a = k0[c], bb = k1[c];
#pragma unroll
        for (int e = 0; e < 4; ++e) { const float q = rdlane(qd, 4 * c + e); s0 += q * a[e]; s1 += q * bb[e]; } }
    const float sink2 = P.in(I_SINK)[h] * LOG2E; const float mx = fmaxf(sink2, wave_max(fmaxf(s0, s1)));
    const float p0 = __builtin_amdgcn_exp2f(s0 - mx), p1 = __builtin_amdgcn_exp2f(s1 - mx); const float l = wave_sum(p0 + p1) + __builtin_amdgcn_exp2f(sink2 - mx);
    float o = 0.f;
#pragma unroll
    for (int i = 0; i < 64; ++i) o += rdlane(p0, i) * vw[(size_t)i * 256 + lane];
#pragma unroll
    for (int i = 0; i < 64; ++i) o += rdlane(p1, i) * vw[(size_t)(64 + i) * 256 + lane];
    O[(size_t)(MPROMPT + b) * DM + h * 64 + lane] = (bf16_t)f2bf(o / l);
}


#define XB_TMO      128
#define XB_XCNT(j)  (256  + 64 * (j))
#define XB_XSUB(j)  (1280 + 64 * (j))
#define XB_XGEN(j)  (2304 + 64 * (j))
#define XB_TOP      3328
#define XB_TOPGEN   3392
#define XCD_BAR_WORDS 3456
#define XB_SPIN_CAP (1u << 18)
__device__ __forceinline__ unsigned xb_ld(unsigned* p)              { return __hip_atomic_load(p, __ATOMIC_RELAXED, __HIP_MEMORY_SCOPE_AGENT); }
__device__ __forceinline__ unsigned xb_add(unsigned* p, unsigned v) { return __hip_atomic_fetch_add(p, v, __ATOMIC_RELAXED, __HIP_MEMORY_SCOPE_AGENT); }
__device__ __forceinline__ unsigned xb_xcc_id() { return (unsigned)__builtin_amdgcn_s_getreg((3 << 11) | 20) & 0xFu; }
#define XB_SPIN(cond, bar) do { unsigned _sp = 0; while (cond) { __builtin_amdgcn_s_sleep(1); \
    if ((++_sp & 255u) == 0u) { if (xb_ld(&(bar)[XB_TMO])) break; if (_sp > XB_SPIN_CAP) { atomicAdd(&(bar)[XB_TMO], 1u); break; } } } } while (0)
struct XcdBarrier { unsigned* bar; unsigned x; volatile LAS unsigned* st; };
__device__ __forceinline__ XcdBarrier xcd_barrier_post(unsigned* bar, volatile LAS unsigned* st) {
    XcdBarrier b; b.bar = bar; b.x = xb_xcc_id(); b.st = st;
    if (threadIdx.x == 0) (void)xb_add(&bar[XB_XCNT(b.x)], 1u);
    return b;
}
__device__ __forceinline__ void xcd_barrier_complete(unsigned* bar, unsigned x, unsigned& nloc, unsigned& nx) {
    const unsigned G = gridDim.x * gridDim.y * gridDim.z;
    unsigned sum, cnt, mine, sp = 0u;
    for (;;) {
        sum = 0u; cnt = 0u; mine = 0u;
#pragma unroll
        for (unsigned j = 0; j < 16; ++j) { const unsigned c = xb_ld(&bar[XB_XCNT(j)]); sum += c; cnt += (c > 0u) ? 1u : 0u; mine = (j == x) ? c : mine; }
        if (sum == G) break;
        __builtin_amdgcn_s_sleep(1);
        if ((++sp & 255u) == 0u) { if (xb_ld(&bar[XB_TMO])) break; if (sp > XB_SPIN_CAP) { atomicAdd(&bar[XB_TMO], 1u); break; } }
    }
    nloc = mine > 0u ? mine : 1u; nx = cnt > 0u ? cnt : 1u;
}
__device__ __forceinline__ void xcd_barrier(const XcdBarrier& b) {
    asm volatile("s_waitcnt vmcnt(0)" ::: "memory");
    __syncthreads();
    if (threadIdx.x == 0) {
        unsigned* bar = b.bar;
        __builtin_amdgcn_s_waitcnt(0);
        unsigned nloc = b.st[0], nx = b.st[1];
        if (nloc == 0u) { xcd_barrier_complete(bar, b.x, nloc, nx); b.st[0] = nloc; b.st[1] = nx; }
        const unsigned old = xb_add(&bar[XB_XSUB(b.x)], 1u);
        const unsigned gen = old / nloc;
        if (old + 1u == (gen + 1u) * nloc) {
            __builtin_amdgcn_fence(__ATOMIC_RELEASE, "agent");
            asm volatile("s_waitcnt vmcnt(0)" ::: "memory");
            const unsigned og = xb_add(&bar[XB_TOP], 1u);
            const unsigned tg = og / nx;
            if (og + 1u == (tg + 1u) * nx) xb_add(&bar[XB_TOPGEN], 1u);
            else XB_SPIN(xb_ld(&bar[XB_TOPGEN]) == tg, bar);
            __builtin_amdgcn_fence(__ATOMIC_ACQUIRE, "agent");
            xb_add(&bar[XB_XGEN(b.x)], 1u);
            asm volatile("s_waitcnt vmcnt(0)" ::: "memory");
        } else {
            XB_SPIN(xb_ld(&bar[XB_XGEN(b.x)]) == gen, bar);
            __builtin_amdgcn_fence(__ATOMIC_ACQUIRE, "agent");
            asm volatile("s_waitcnt vmcnt(0)" ::: "memory");
        }
    }
    __syncthreads();
}

__global__ void __launch_bounds__(512, 2) yoco_fwd(Params Punused) {
    extern __shared__ __attribute__((aligned(16))) unsigned char lds_raw[];
    LAS unsigned char* lds = (LAS unsigned char*)lds_raw;
    cg::grid_group grid = cg::this_grid();
    const int tid = threadIdx.x, lane = tid & 63, wave = __builtin_amdgcn_readfirstlane(tid >> 6);
    const int G = gridDim.x, gw = blockIdx.x * 8 + wave, NGW = G * 8;
    KA P; P.p = (kaptr_t)__builtin_amdgcn_kernarg_segment_ptr();
    if (tid < 64) ((volatile LAS unsigned*)(lds + 131072))[tid] = 0u;
    __syncthreads();
    (void)xcd_barrier_post((unsigned*)(P.ws() + WS_CTL), (volatile LAS unsigned*)(lds + 131072) + 8);
    if (gridDim.x == 0x7fffffffu) grid.sync();
#define GRID_BAR() do { KA Pb = P; asm volatile("" : "+s"(Pb.p)); XcdBarrier xb_; xb_.bar = (unsigned*)(Pb.ws() + WS_CTL); xb_.x = xb_xcc_id(); xb_.st = (volatile LAS unsigned*)(lds + 131072) + 8; xcd_barrier(xb_); } while (0)
#define LAUNDER() KA Pl = P; int lane_l = lane, tid_l = tid; asm volatile("" : "+s"(Pl.p)); asm volatile("" : "+v"(lane_l), "+v"(tid_l))

#ifndef NO_PRO
    { LAUNDER(); prologue(Pl, lds, gw, NGW, wave, lane_l); }
#endif
    GRID_BAR();

    for (int ph = 0; ph < 14; ++ph) {
        if (ph == 2) {
#ifndef NO_POOL
            { LAUNDER(); pool_phase(Pl, gw, NGW, lane_l); }
#endif
        }
        else if (ph == 9) {
            LAUNDER();
#ifndef NO_ATTNP
            for (int u = blockIdx.x; u < 512; u += G) { const int kvh = u & 3, n = (u >> 2) & 31, b = u >> 7; attn_prompt_unit(Pl, lds, b, n, kvh, tid_l, wave, lane_l); }
#endif
#ifndef NO_ATTNS
            for (int t = gw; t < 2048; t += NGW) attn_sample_task(Pl, t >> 4, t & 15, lane_l);
#endif
        }
        else if (ph == 13) {
            LAUNDER();
            for (int row = gw; row < MV; row += NGW) {
                const float rs = rstd_row((const float*)(Pl.ws() + WS_SSQ), row); f32x4* xr = (f32x4*)(Pl.out() + (size_t)row * DM) + lane_l; const f32x4* gr = (const f32x4*)Pl.in(I_FING) + lane_l;
#pragma unroll
                for (int j = 0; j < 4; ++j) xr[64 * j] = xr[64 * j] * rs * gr[64 * j];
            }
        }
        else {
            LAUNDER(); unsigned char* ws = Pl.ws();
            pg8::Gemm g; g.M = MP; g.a_pn_stride = 0; Epi E;
            E.ws = ws; E.out = Pl.out();
            const int f = (ph <= 1) ? 0 : (ph <= 5) ? 1 : (ph <= 7) ? 2 : 3;
            if (ph == 0 || ph == 4 || ph == 6 || ph == 11) { g.A = (const bf16_t*)(ws + WS_XB); g.Bt = (const bf16_t*)(ws + WS_WGU + f * WGU_STRIDE); g.N = (ph == 6) ? 6144 : 5632; g.K = DM; E.kind = E_SWIGLU; }
            else if (ph == 1 || ph == 5 || ph == 7 || ph == 12) { g.A = (const bf16_t*)(ws + WS_H); g.Bt = (const bf16_t*)(ws + WS_WD + f * WD_STRIDE); g.N = DM; g.K = DFF; E.kind = E_RESID; }
            else if (ph == 3) { g.A = (const bf16_t*)(ws + WS_H); g.a_pn_stride = (size_t)MP * 256 * 2; g.Bt = (const bf16_t*)(ws + WS_WPOOL); g.N = DM; g.K = 256; E.kind = E_RESID; }
            else if (ph == 8) { g.A = (const bf16_t*)(ws + WS_XB); g.Bt = (const bf16_t*)(ws + WS_WQ); g.N = DM; g.K = DM; E.kind = E_Q; }
            else { g.A = (const bf16_t*)(ws + WS_O); g.Bt = (const bf16_t*)(ws + WS_WO); g.N = DM; g.K = DM; E.kind = E_RESID; }
            pg8::StaticOrder S; S.init(MP, g.N, G, (int)blockIdx.x);
#ifndef NO_GEMM
            pg8::gemm_phase<Epi>(lds, g, S, E);
#endif
        }
        if (ph < 13) GRID_BAR();
    }
}

extern "C" void kernel_launch(void* const* d_in, const int* in_sizes, int n_in, void* d_out, int out_size, void* d_ws, size_t ws_size, hipStream_t stream) {
    static int grid = 0;
    if (grid == 0) {
        int dev = 0, cus = 0, per_cu = 0;
        if (n_in != 17 || ws_size < WS_END) { fprintf(stderr, "kernel_launch: unexpected n_in %d / ws %zu\n", n_in, ws_size); grid = -1; return; }
        hipGetDevice(&dev); hipDeviceGetAttribute(&cus, hipDeviceAttributeMultiprocessorCount, dev);
        if (hipFuncSetAttribute((const void*)yoco_fwd, hipFuncAttributeMaxDynamicSharedMemorySize, LDS_BYTES) != hipSuccess) { fprintf(stderr, "kernel_launch: hipFuncSetAttribute failed\n"); grid = -1; return; }
        if (hipOccupancyMaxActiveBlocksPerMultiprocessor(&per_cu, (const void*)yoco_fwd, 512, LDS_BYTES) != hipSuccess || per_cu < 1) { fprintf(stderr, "kernel_launch: occupancy query says %d\n", per_cu); per_cu = 1; }
        (void)hipGetLastError();
        grid = cus;
    }
    if (grid < 0) return;
    if (hipMemsetAsync((char*)d_ws + WS_CTL, 0, XCD_BAR_WORDS * 4, stream) != hipSuccess) { fprintf(stderr, "kernel_launch: memset failed\n"); return; }
    Params p{};
    for (int i = 0; i < 17; ++i) p.in[i] = (const float*)d_in[i];
    p.out = (float*)d_out; p.ws = (unsigned char*)d_ws;
    void* args[] = {&p};
    hipError_t e = hipLaunchCooperativeKernel((const void*)yoco_fwd, dim3(grid), dim3(512), args, LDS_BYTES, stream);
    if (e != hipSuccess) fprintf(stderr, "cooperative launch failed: %s (grid %d)\n", hipGetErrorString(e), grid);
}
```
